# Optimizing an MI355X kernel written in HIP

```python
import math
import jax, jax.numpy as jnp
from jax import lax
import numpy as np

D_MODEL = 1024
BATCH = 4
SEQ = 8192
DEPTH = 2

HEAD_DIM = 64
ROPE_THETA = 10000.0
BLOCK = 128
EPS = 1e-6

A_HEADS = 4
A_VDIM = 2 * HEAD_DIM
A_WIDTH = A_HEADS * A_VDIM
A_QK = A_HEADS * 2 * HEAD_DIM
B_HEADS = 8
B_KV_HEADS = 2
B_WIDTH = B_HEADS * HEAD_DIM
B_KV = B_KV_HEADS * HEAD_DIM
WINDOW = 128
C_HEADS = 16
C_WIDTH = C_HEADS * HEAD_DIM

EVEN_SIZES = (A_QK, A_QK, A_WIDTH, A_WIDTH, B_WIDTH, B_KV, B_KV, B_WIDTH)
EVEN_IN = sum(EVEN_SIZES)
EVEN_MIX = A_WIDTH + B_WIDTH
ODD_IN = 4 * C_WIDTH
N_EVEN = (DEPTH + 1) // 2
N_ODD = DEPTH // 2

kernel_name = "hybrid_diffattn_swa_sink_stickbreaking_adaln"


def _split_points(sizes):
    pts, acc = [], 0
    for s in sizes[:-1]:
        acc += s
        pts.append(acc)
    return pts


def rms_norm(x, g):
    xf = x.astype(jnp.float32)
    y = xf * lax.rsqrt(jnp.mean(xf * xf, axis=-1, keepdims=True) + EPS)
    return (y * g.astype(jnp.float32)).astype(x.dtype)


def rope(x, pos):
    half = x.shape[-1] // 2
    inv = ROPE_THETA ** (-jnp.arange(half, dtype=jnp.float32) / half)
    ang = pos.astype(jnp.float32)[..., None] * inv
    cos = jnp.cos(ang)[:, :, None, :]
    sin = jnp.sin(ang)[:, :, None, :]
    xf = x.astype(jnp.float32)
    x1, x2 = xf[..., :half], xf[..., half:]
    out = jnp.concatenate([x1 * cos - x2 * sin, x2 * cos + x1 * sin], axis=-1)
    return out.astype(x.dtype)


def modulate(x, c, norm_g, w_mod, b_mod):
    mod = jax.nn.silu(c) @ w_mod + b_mod
    shift, scale, gate = jnp.split(mod, 3, axis=-1)
    h = rms_norm(x, norm_g) * (1 + scale[:, None, :]) + shift[:, None, :]
    return h, gate[:, None, :]


def diff_attention(q, k, v, lam):
    B, S, H, _, d = q.shape
    nb = S // BLOCK
    scale = d ** -0.5
    qb = q.astype(jnp.float32).reshape(B, nb, BLOCK, H, 2, d).transpose(1, 0, 2, 3, 4, 5)
    kf = k.astype(jnp.float32)
    vf = v.astype(jnp.float32)
    key_idx = jnp.arange(S)

    def block(args):
        qi, i = args
        s = jnp.einsum('bthcd,bshcd->bhcts', qi, kf) * scale
        q_idx = i * BLOCK + jnp.arange(BLOCK)
        mask = key_idx[None, :] <= q_idx[:, None]
        p = jax.nn.softmax(jnp.where(mask, s, -jnp.inf), axis=-1)
        w = p[:, :, 0] - lam * p[:, :, 1]
        return jnp.einsum('bhts,bshe->bthe', w, vf)

    out = lax.map(block, (qb, jnp.arange(nb)))
    return out.transpose(1, 0, 2, 3, 4).reshape(B, S, H, 2 * d).astype(v.dtype)


def sliding_window_sink_attention(q, k, v, sinks):
    B, S, Hq, d = q.shape
    Hkv = k.shape[2]
    G = Hq // Hkv
    nb = S // BLOCK
    scale = d ** -0.5
    qb = q.astype(jnp.float32).reshape(B, nb, BLOCK, Hkv, G, d)
    kb = k.astype(jnp.float32).reshape(B, nb, BLOCK, Hkv, d)
    vb = v.astype(jnp.float32).reshape(B, nb, BLOCK, Hkv, d)
    prev = lambda t: jnp.concatenate([jnp.zeros_like(t[:, :1]), t[:, :-1]], axis=1)
    kk = jnp.concatenate([prev(kb), kb], axis=2)
    vv = jnp.concatenate([prev(vb), vb], axis=2)
    s = jnp.einsum('bntkgd,bnskd->bnkgts', qb, kk) * scale
    t_rel = jnp.arange(BLOCK)[:, None] + BLOCK
    s_rel = jnp.arange(2 * BLOCK)[None, :]
    blk = jnp.arange(nb)[:, None, None]
    mask = (s_rel <= t_rel) & (t_rel - s_rel < WINDOW) & ((blk > 0) | (s_rel >= BLOCK))
    s = jnp.where(mask[None, :, None, None], s, -jnp.inf)
    sink = sinks.astype(jnp.float32).reshape(Hkv, G)[None, None, :, :, None, None]
    m = jnp.maximum(jnp.max(s, axis=-1, keepdims=True), sink)
    e = jnp.exp(s - m)
    p = e / (jnp.sum(e, axis=-1, keepdims=True) + jnp.exp(sink - m))
    out = jnp.einsum('bnkgts,bnskd->bntkgd', p, vv)
    return out.reshape(B, S, Hq, d).astype(v.dtype)


def stick_breaking_attention(q, k, v):
    B, S, H, d = q.shape
    nb = S // BLOCK
    scale = d ** -0.5
    qb = q.astype(jnp.float32).reshape(B, nb, BLOCK, H, d).transpose(1, 0, 2, 3, 4)
    kf = k.astype(jnp.float32)
    vf = v.astype(jnp.float32)
    key_idx = jnp.arange(S)

    def block(args):
        qi, i = args
        z = jnp.einsum('bthd,bshd->bhts', qi, kf) * scale
        q_idx = i * BLOCK + jnp.arange(BLOCK)
        strict = key_idx[None, :] < q_idx[:, None]
        log_1m = jnp.where(strict, jax.nn.log_sigmoid(-z), 0.0)
        suffix = lax.cumsum(log_1m, axis=3, reverse=True) - log_1m
        w = jnp.where(strict, jnp.exp(jax.nn.log_sigmoid(z) + suffix), 0.0)
        return jnp.einsum('bhts,bshd->bthd', w, vf)

    out = lax.map(block, (qb, jnp.arange(nb)))
    return out.transpose(1, 0, 2, 3, 4).reshape(B, S, H, d).astype(v.dtype)


def even_layer(x, c, positions, layer, norm_g, w_mod, b_mod, w_in, a_q_gain, a_k_gain,
               lq1, lk1, lq2, lk2, a_subln_g, b_q_gain, b_k_gain, b_sinks, w_out):
    B, S, _ = x.shape
    h, gate = modulate(x, c, norm_g, w_mod, b_mod)
    u = h @ w_in
    qa, ka, va, ga, qb, kb, vb, gb = jnp.split(u, _split_points(EVEN_SIZES), axis=-1)
    qa = rope(rms_norm(qa.reshape(B, S, 2 * A_HEADS, HEAD_DIM), a_q_gain), positions)
    ka = rope(rms_norm(ka.reshape(B, S, 2 * A_HEADS, HEAD_DIM), a_k_gain), positions)
    lambda_init = 0.8 - 0.6 * math.exp(-0.3 * layer)
    f32 = jnp.float32
    lam = (jnp.exp(jnp.sum(lq1.astype(f32) * lk1.astype(f32)))
           - jnp.exp(jnp.sum(lq2.astype(f32) * lk2.astype(f32))) + lambda_init)
    ya = diff_attention(qa.reshape(B, S, A_HEADS, 2, HEAD_DIM),
                        ka.reshape(B, S, A_HEADS, 2, HEAD_DIM),
                        va.reshape(B, S, A_HEADS, A_VDIM), lam)
    ya = (rms_norm(ya, a_subln_g) * (1 - lambda_init)).reshape(B, S, A_WIDTH)
    qb = rope(rms_norm(qb.reshape(B, S, B_HEADS, HEAD_DIM), b_q_gain), positions)
    kb = rope(rms_norm(kb.reshape(B, S, B_KV_HEADS, HEAD_DIM), b_k_gain), positions)
    yb = sliding_window_sink_attention(qb, kb, vb.reshape(B, S, B_KV_HEADS, HEAD_DIM), b_sinks)
    yb = yb.reshape(B, S, B_WIDTH)
    y = jnp.concatenate([ya * jax.nn.silu(ga), yb * jax.nn.silu(gb)], axis=-1) @ w_out
    return x + gate * y


def odd_layer(x, c, norm_g, w_mod, b_mod, w_in, w_out):
    B, S, _ = x.shape
    h, gate = modulate(x, c, norm_g, w_mod, b_mod)
    q, k, v, g = jnp.split(h @ w_in, 4, axis=-1)
    shp = (B, S, C_HEADS, HEAD_DIM)
    y = stick_breaking_attention(q.reshape(shp), k.reshape(shp), v.reshape(shp)).reshape(B, S, C_WIDTH)
    y = (y * jax.nn.silu(g)) @ w_out
    return x + gate * y


def setup_inputs(seed: int = 0) -> dict:
    key = jax.random.key(seed)
    ks = iter(jax.random.split(key, 32))
    nrm = lambda shape, s: jax.random.normal(next(ks), shape, jnp.float32) * s
    D = D_MODEL
    return {
        "x": nrm((BATCH, SEQ, D), 1.0),
        "c": nrm((BATCH, D), 1.0),
        "positions": jnp.broadcast_to(jnp.arange(SEQ, dtype=jnp.int32), (BATCH, SEQ)),
        "even_norm_g": 1.0 + nrm((N_EVEN, D), 0.05),
        "even_w_mod": nrm((N_EVEN, D, 3 * D), 0.2 * D ** -0.5),
        "even_b_mod": nrm((N_EVEN, 3 * D), 0.02),
        "even_w_in": nrm((N_EVEN, D, EVEN_IN), D ** -0.5),
        "a_q_gain": 1.0 + nrm((N_EVEN, HEAD_DIM), 0.05),
        "a_k_gain": 1.0 + nrm((N_EVEN, HEAD_DIM), 0.05),
        "a_lambda_q1": nrm((N_EVEN, HEAD_DIM), 0.1),
        "a_lambda_k1": nrm((N_EVEN, HEAD_DIM), 0.1),
        "a_lambda_q2": nrm((N_EVEN, HEAD_DIM), 0.1),
        "a_lambda_k2": nrm((N_EVEN, HEAD_DIM), 0.1),
        "a_subln_g": 1.0 + nrm((N_EVEN, A_VDIM), 0.05),
        "b_q_gain": 1.0 + nrm((N_EVEN, HEAD_DIM), 0.05),
        "b_k_gain": 1.0 + nrm((N_EVEN, HEAD_DIM), 0.05),
        "b_sinks": nrm((N_EVEN, B_HEADS), 0.5),
        "even_w_out": nrm((N_EVEN, EVEN_MIX, D), EVEN_MIX ** -0.5),
        "odd_norm_g": 1.0 + nrm((N_ODD, D), 0.05),
        "odd_w_mod": nrm((N_ODD, D, 3 * D), 0.2 * D ** -0.5),
        "odd_b_mod": nrm((N_ODD, 3 * D), 0.02),
        "odd_w_in": nrm((N_ODD, D, ODD_IN), D ** -0.5),
        "odd_w_out": nrm((N_ODD, C_WIDTH, D), C_WIDTH ** -0.5),
    }


def reference(x, c, positions, even_norm_g, even_w_mod, even_b_mod, even_w_in, a_q_gain, a_k_gain,
              a_lambda_q1, a_lambda_k1, a_lambda_q2, a_lambda_k2, a_subln_g, b_q_gain, b_k_gain,
              b_sinks, even_w_out, odd_norm_g, odd_w_mod, odd_b_mod, odd_w_in, odd_w_out):
    for layer in range(DEPTH):
        j = layer // 2
        if layer % 2 == 0:
            x = even_layer(x, c, positions, layer, even_norm_g[j], even_w_mod[j], even_b_mod[j],
                           even_w_in[j], a_q_gain[j], a_k_gain[j], a_lambda_q1[j], a_lambda_k1[j],
                           a_lambda_q2[j], a_lambda_k2[j], a_subln_g[j], b_q_gain[j], b_k_gain[j],
                           b_sinks[j], even_w_out[j])
        else:
            x = odd_layer(x, c, odd_norm_g[j], odd_w_mod[j], odd_b_mod[j], odd_w_in[j], odd_w_out[j])
    return x
```

```cpp
#include <hip/hip_runtime.h>
#include <hip/hip_cooperative_groups.h>
#include <cstdio>
#include <cstdint>
namespace cg = cooperative_groups;
namespace pg8 {
#define PG8_LAS __attribute__((address_space(3)))
typedef unsigned short bf16_t;
typedef short bf16x8 __attribute__((ext_vector_type(8)));
typedef float f32x4 __attribute__((ext_vector_type(4)));
typedef unsigned u32x4 __attribute__((ext_vector_type(4)));
constexpr int BM = 256, BK = 64, HALF = 128, HTB = HALF * BK * 2  , STAGE_BYTES = 8 * HTB, NXCD = 8, WGM = 8;

__host__ __device__ __forceinline__ int lds_byte(int r, int c) { const int st = (r >> 4) * 2 + (c >> 5), rr = r & 15, cc = c & 31, ob = rr * 64 + cc * 2; return st * 1024 + (ob ^ (((ob >> 9) & 1) << 5)); }
__host__ __device__ __forceinline__ void stage_rc(int b, int& R, int& C) { const int st = b / 1024, sb = b % 1024, swz = sb ^ (((sb >> 9) & 1) << 5); R = (st >> 1) * 16 + swz / 64; C = (st & 1) * 32 + (swz % 64) / 2; }
__host__ __device__ __forceinline__ int perm32(int rho) { const int n = rho >> 4, i = rho & 15; return 8 * (i >> 2) + 4 * n + (i & 3); }

struct Unit { int pm, pn; };
struct Gemm { const bf16_t* A; const bf16_t* Bt; int M, N, K; };

struct StaticOrder {
    int nM, nN, nwg, G, c;
    __host__ __device__ void init(int M, int N, int G_, int c_) { nM = M / BM; nN = N / BM; nwg = nM * nN; G = G_; c = c_; }
    __host__ __device__ bool next(int i, Unit& u) const {
        const long L = (long)i * G + c; if (L >= nwg) return false;
        int wgid = (int)L; { const int q = nwg / NXCD, r = nwg % NXCD, xcd = wgid % NXCD, off = wgid / NXCD; wgid = (xcd < r ? xcd * (q + 1) : r * (q + 1) + (xcd - r) * q) + off; }
        const int nig = WGM * nN, gid = wgid / nig, fm = gid * WGM, gsz = (nM - fm) < WGM ? (nM - fm) : WGM;
        u.pm = fm + ((wgid % nig) % gsz); u.pn = (wgid % nig) / gsz; return true;
    }
    __device__ __forceinline__ void a_ready(const Unit&) const {}
    __device__ __forceinline__ void done(const Unit&) const {}
};

__device__ __forceinline__ unsigned cvt_pk_bf16(float lo, float hi) { unsigned r; asm volatile("v_cvt_pk_bf16_f32 %0, %1, %2" : "=v"(r) : "v"(lo), "v"(hi)); return r; }
typedef float f32x2 __attribute__((ext_vector_type(2)));
template <class Epi, class Sched, bool ALIGN_EPI = false, bool SP2 = false>
__device__ __forceinline__ void gemm_phase(PG8_LAS unsigned char* lds, const Gemm g, const Sched& S, const Epi& E, const int wid) {
    int lane; asm volatile("v_mbcnt_lo_u32_b32 %0, -1, 0\n\tv_mbcnt_hi_u32_b32 %0, -1, %0" : "=v"(lane));
    const int tid = wid * 64 + lane, wr = wid >> 2, wc = wid & 3, fr = lane & 15, fq = lane >> 4;
    const int K = g.K, nt = K / BK;
    unsigned voffA[2], voffB[2];
#pragma unroll
    for (int i = 0; i < 2; ++i) { int R, C; stage_rc(tid * 16 + i * 8192, R, C); const int Rb = Epi::PERM ? ((R & ~31) + perm32(R & 31)) : R;
        voffA[i] = (unsigned)(R * K + C) * 2u; voffB[i] = (unsigned)(Rb * K + C) * 2u; }
    const size_t kstep = (size_t)(BK * 2);
    const size_t hstep = (size_t)HALF * K * 2;
    const size_t tstep = 2 * hstep;
    const unsigned ldsw = (unsigned)wid * 1024u;
    const int aoff = lds_byte(wr * 64 + fr, fq * 8), boff = lds_byte(wc * 32 + fr, fq * 8);
#define PG8_SA(b, h) (((b) * 2 + (h)) * HTB)
#define PG8_SB(b, h) ((4 + (b) * 2 + (h)) * HTB)
#define PG8_STAGE(bufoff, gbase, voff) do { _Pragma("unroll") for (int _i = 0; _i < 2; ++_i) \
        __builtin_amdgcn_global_load_lds((const unsigned*)((const char*)(gbase) + (voff)[_i]), (PG8_LAS unsigned*)(lds + (bufoff) + ldsw + _i * 8192), 16, 0, 0); } while (0)
#define PG8_LDA(dst, b, h) do { _Pragma("unroll") for (int m = 0; m < 4; ++m) _Pragma("unroll") for (int k = 0; k < 2; ++k) dst[m][k] = *(const PG8_LAS bf16x8*)(lds + PG8_SA(b, h) + aoff + m * 2048 + k * 1024); } while (0)
#define PG8_LDB(dst, b, h) do { _Pragma("unroll") for (int n = 0; n < 2; ++n) _Pragma("unroll") for (int k = 0; k < 2; ++k) dst[n][k] = *(const PG8_LAS bf16x8*)(lds + PG8_SB(b, h) + boff + n * 2048 + k * 1024); } while (0)
#define PG8_MMA(ai, bj, At, Bt) do { __builtin_amdgcn_s_setprio(1); _Pragma("unroll") for (int m = 0; m < 4; ++m) _Pragma("unroll") for (int n = 0; n < 2; ++n) _Pragma("unroll") for (int k = 0; k < 2; ++k) \
        acc[ai][bj][m][n] = __builtin_amdgcn_mfma_f32_16x16x32_bf16(Bt[n][k], At[m][k], acc[ai][bj][m][n], 0, 0, 0); __builtin_amdgcn_s_setprio(0); } while (0)
#define PG8_WAIT_V(n) asm volatile("s_waitcnt vmcnt(" #n ")" ::: "memory")
#define PG8_WAIT_L(n) asm volatile("s_waitcnt lgkmcnt(" #n ")" ::: "memory")
#define PG8_BAR __builtin_amdgcn_s_barrier()
#define PG8_SCHED __builtin_amdgcn_sched_barrier(0)
    Unit cur, nxt; int ui = 0;
    if (!S.next(0, cur)) return;
    f32x4 acc[2][2][4][2];
#pragma unroll
    for (int a = 0; a < 2; ++a)
#pragma unroll
        for (int b = 0; b < 2; ++b)
#pragma unroll
            for (int m = 0; m < 4; ++m)
#pragma unroll
                for (int n = 0; n < 2; ++n) acc[a][b][m][n] = (f32x4){0.f, 0.f, 0.f, 0.f};
    bf16x8 At[4][2], B0[2][2], B1[2][2];
    const char* cA = (const char*)g.A + (size_t)cur.pm * tstep; const char* cB = (const char*)g.Bt + (size_t)cur.pn * tstep;
    S.a_ready(cur);
    if constexpr (SP2) {
        PG8_STAGE(PG8_SB(0, 0), cB, voffB); PG8_STAGE(PG8_SB(0, 1), cB + hstep, voffB); PG8_STAGE(PG8_SA(0, 0), cA, voffA); PG8_STAGE(PG8_SA(0, 1), cA + hstep, voffA);
        if (wr == 1) PG8_BAR;
        PG8_WAIT_V(2); PG8_BAR;
        PG8_STAGE(PG8_SB(1, 0), cB + kstep, voffB); PG8_STAGE(PG8_SA(1, 0), cA + kstep, voffA); PG8_STAGE(PG8_SB(1, 1), cB + hstep + kstep, voffB);
        PG8_WAIT_V(6); PG8_BAR;
    } else {
        PG8_STAGE(PG8_SB(0, 0), cB, voffB); PG8_STAGE(PG8_SA(0, 0), cA, voffA); PG8_STAGE(PG8_SB(0, 1), cB + hstep, voffB); PG8_STAGE(PG8_SA(0, 1), cA + hstep, voffA);
        if (wr == 1) PG8_BAR;
        PG8_WAIT_V(4); PG8_BAR;
        PG8_STAGE(PG8_SB(1, 0), cB + kstep, voffB); PG8_STAGE(PG8_SA(1, 0), cA + kstep, voffA); PG8_STAGE(PG8_SB(1, 1), cB + hstep + kstep, voffB);
        PG8_WAIT_V(6); PG8_BAR;
    }
    for (;;) {
        const bool has_next = S.next(ui + 1, nxt);
        const char* nA = has_next ? (const char*)g.A + (size_t)nxt.pm * tstep : cA; const char* nB = has_next ? (const char*)g.Bt + (size_t)nxt.pn * tstep : cB;
        for (int t = 0; t < nt; t += 2) {
            const bool last = (t == nt - 2);
            const char* a1 = cA + (size_t)(t + 1) * kstep;
            const char* a2 = last ? nA : cA + (size_t)(t + 2) * kstep; const char* b2 = last ? nB : cB + (size_t)(t + 2) * kstep;
            const char* a3 = a2 + kstep; const char* b3 = b2 + kstep;
            if (last && has_next) S.a_ready(nxt);
            if constexpr (SP2) {
            PG8_LDB(B0, 0, 0); PG8_LDB(B1, 0, 1); PG8_SCHED; PG8_LDA(At, 0, 0); PG8_STAGE(PG8_SA(1, 1), a1 + hstep, voffA);
            PG8_WAIT_V(8); PG8_WAIT_L(0); PG8_BAR; PG8_MMA(0, 0, At, B0); PG8_MMA(0, 1, At, B1); PG8_BAR; PG8_SCHED;
            PG8_LDA(At, 0, 1); PG8_STAGE(PG8_SB(0, 0), b2, voffB); PG8_STAGE(PG8_SB(0, 1), b2 + hstep, voffB); PG8_STAGE(PG8_SA(0, 0), a2, voffA);
            PG8_WAIT_V(8); PG8_WAIT_L(0); PG8_BAR; PG8_MMA(1, 0, At, B0); PG8_MMA(1, 1, At, B1); PG8_BAR; PG8_SCHED;
            PG8_LDB(B0, 1, 0); PG8_LDB(B1, 1, 1); PG8_SCHED; PG8_LDA(At, 1, 0); PG8_STAGE(PG8_SA(0, 1), a2 + hstep, voffA);
            PG8_WAIT_V(8); PG8_WAIT_L(0); PG8_BAR; PG8_MMA(0, 0, At, B0); PG8_MMA(0, 1, At, B1); PG8_BAR; PG8_SCHED;
            PG8_LDA(At, 1, 1); PG8_STAGE(PG8_SB(1, 0), b3, voffB); PG8_STAGE(PG8_SB(1, 1), b3 + hstep, voffB); PG8_STAGE(PG8_SA(1, 0), a3, voffA);
            PG8_WAIT_V(8); PG8_WAIT_L(0); PG8_BAR; PG8_MMA(1, 0, At, B0); PG8_MMA(1, 1, At, B1); PG8_BAR; PG8_SCHED;
            } else {
            PG8_LDB(B0, 0, 0); PG8_SCHED; PG8_LDA(At, 0, 0); PG8_STAGE(PG8_SA(1, 1), a1 + hstep, voffA);
            PG8_WAIT_L(8); PG8_BAR; PG8_WAIT_L(0); PG8_MMA(0, 0, At, B0); PG8_BAR; PG8_SCHED;
            PG8_LDB(B1, 0, 1); PG8_STAGE(PG8_SB(0, 0), b2, voffB);
            PG8_BAR; PG8_WAIT_L(0); PG8_MMA(0, 1, At, B1); PG8_BAR;
            PG8_LDA(At, 0, 1); PG8_STAGE(PG8_SA(0, 0), a2, voffA);
            PG8_BAR; PG8_WAIT_L(0); PG8_MMA(1, 0, At, B0); PG8_BAR; PG8_SCHED;
            PG8_STAGE(PG8_SB(0, 1), b2 + hstep, voffB);
            PG8_WAIT_V(6); PG8_BAR; PG8_MMA(1, 1, At, B1); PG8_BAR;
            PG8_LDB(B0, 1, 0); PG8_SCHED; PG8_LDA(At, 1, 0); PG8_STAGE(PG8_SA(0, 1), a2 + hstep, voffA);
            PG8_WAIT_L(8); PG8_BAR; PG8_WAIT_L(0); PG8_MMA(0, 0, At, B0); PG8_BAR; PG8_SCHED;
            PG8_LDB(B1, 1, 1); PG8_STAGE(PG8_SB(1, 0), b3, voffB);
            PG8_BAR; PG8_WAIT_L(0); PG8_MMA(0, 1, At, B1); PG8_BAR;
            PG8_LDA(At, 1, 1); PG8_STAGE(PG8_SA(1, 0), a3, voffA);
            PG8_BAR; PG8_WAIT_L(0); PG8_MMA(1, 0, At, B0); PG8_BAR; PG8_SCHED;
            PG8_STAGE(PG8_SB(1, 1), b3 + hstep, voffB);
            PG8_WAIT_V(6); PG8_BAR; PG8_MMA(1, 1, At, B1); PG8_BAR;
            }
        }
        if constexpr (ALIGN_EPI) { if (wr == 0) PG8_BAR; }
        if constexpr (!Epi::AFTER_DRAIN) { E(acc, cur, wr, wc, fr, fq); S.done(cur); }
        if (!has_next) break;
#pragma unroll
        for (int a = 0; a < 2; ++a)
#pragma unroll
            for (int b = 0; b < 2; ++b)
#pragma unroll
                for (int m = 0; m < 4; ++m)
#pragma unroll
                    for (int n = 0; n < 2; ++n) acc[a][b][m][n] = (f32x4){0.f, 0.f, 0.f, 0.f};
        cur = nxt; cA = nA; cB = nB; ++ui;
        if constexpr (ALIGN_EPI) { if (wr == 1) PG8_BAR; }
    }
    PG8_WAIT_V(0);
    if constexpr (!ALIGN_EPI) { if (wr == 0) PG8_BAR; }
    PG8_BAR;
    if constexpr (Epi::AFTER_DRAIN) { E.fused(acc, cur, wr, wc, fr, fq, lds, wid, lane); S.done(cur); }
#undef PG8_SA
#undef PG8_SB
#undef PG8_STAGE
#undef PG8_LDA
#undef PG8_LDB
#undef PG8_MMA
#undef PG8_WAIT_V
#undef PG8_WAIT_L
#undef PG8_BAR
#undef PG8_SCHED
}
}

namespace pg8 {
struct EpiStore {
    static constexpr bool PERM = true, AFTER_DRAIN = false;
    bf16_t* O; int ldc;
    __device__ __forceinline__ void operator()(const f32x4 (&acc)[2][2][4][2], const Unit& u, int wr, int wc, int fr, int fq) const {
        const int row0 = u.pm * BM + wr * 64 + fr; const int col0 = u.pn * BM + wc * 32 + 8 * fq;
#pragma unroll
        for (int ai = 0; ai < 2; ++ai)
#pragma unroll
            for (int m = 0; m < 4; ++m) { bf16_t* rowp = O + (size_t)(row0 + ai * HALF + m * 16) * ldc + col0;
#pragma unroll
                for (int bj = 0; bj < 2; ++bj) { const f32x4 v0 = acc[ai][bj][m][0], v1 = acc[ai][bj][m][1];
                    u32x4 w; w.x = cvt_pk_bf16(v0[0], v0[1]); w.y = cvt_pk_bf16(v0[2], v0[3]); w.z = cvt_pk_bf16(v1[0], v1[1]); w.w = cvt_pk_bf16(v1[2], v1[3]);
                    *(u32x4*)(rowp + bj * HALF) = w; } }
    }
};
struct EpiResid {
    static constexpr bool PERM = false, AFTER_DRAIN = false;
    const float* base; float* out; const float* gate;
    __device__ __forceinline__ void operator()(const f32x4 (&acc)[2][2][4][2], const Unit& u, int wr, int wc, int fr, int fq) const {
        const int row0 = u.pm * BM + wr * 64 + fr; const int col0 = u.pn * BM + wc * 32 + 4 * fq;
        const float* gb = gate + (size_t)((u.pm * BM) / 8192) * 3072 + col0;
        f32x4 gv[2][2];
#pragma unroll
        for (int bj = 0; bj < 2; ++bj)
#pragma unroll
            for (int n = 0; n < 2; ++n) gv[bj][n] = *(const f32x4*)(gb + bj * HALF + n * 16);
#pragma unroll
        for (int ai = 0; ai < 2; ++ai)
#pragma unroll
            for (int m = 0; m < 4; ++m) { const size_t off = (size_t)(row0 + ai * HALF + m * 16) * 1024 + col0;
#pragma unroll
                for (int bj = 0; bj < 2; ++bj)
#pragma unroll
                    for (int n = 0; n < 2; ++n) { const f32x4 bs = *(const f32x4*)(base + off + bj * HALF + n * 16);
                        *(f32x4*)(out + off + bj * HALF + n * 16) = bs + gv[bj][n] * acc[ai][bj][m][n]; } }
    }
};
}

typedef unsigned short bf16;
typedef short bf16x8 __attribute__((ext_vector_type(8)));
typedef float f32x4 __attribute__((ext_vector_type(4)));
typedef float f32x16 __attribute__((ext_vector_type(16)));
typedef unsigned u32x4 __attribute__((ext_vector_type(4)));
typedef unsigned u32x2 __attribute__((ext_vector_type(2)));
typedef float f32x2_t __attribute__((ext_vector_type(2)));
typedef __bf16 bf16x2_t __attribute__((ext_vector_type(2)));
#define LAS __attribute__((address_space(3)))

constexpr int NB = 4, S = 8192, D = 1024, M = NB * S;
constexpr int EIN = 3328, OIN = 4096, U1LD = 3072, EU = 2816;
constexpr int C_QA = 0, C_KA = 512, C_GA = 1024, C_QB = 1536, C_KB = 2048, C_VB = 2176, C_GB = 2304;
constexpr float LOG2E = 1.4426950408889634f;
constexpr float QS = 0.125f * LOG2E;
constexpr float EPS = 1e-6f;
constexpr int NWAVES = 8;

constexpr size_t MiB = 1u << 20;
constexpr size_t WS_BAR = 0;
constexpr size_t WS_MOD = 1 * MiB;
constexpr size_t WS_WINE = 2 * MiB, WS_WOUTE = 9 * MiB, WS_WINO = 11 * MiB, WS_WOUTO = 19 * MiB;
constexpr size_t WS_H = 32 * MiB;
constexpr size_t WS_VT = 96 * MiB;
constexpr size_t WS_U = 160 * MiB;
constexpr size_t WS_END = 416 * MiB;
constexpr int LDS_BYTES = 147456;
constexpr int LDS_SCR = 65536;
constexpr int LDS_MISC = 135168;

__device__ __forceinline__ unsigned cvtpk(float lo, float hi) { f32x2_t v = {lo, hi}; bf16x2_t b = __builtin_convertvector(v, bf16x2_t); return __builtin_bit_cast(unsigned, b); }
__device__ __forceinline__ float bf_lo(unsigned w) { return __uint_as_float(w << 16); }
__device__ __forceinline__ float bf_hi(unsigned w) { return __uint_as_float(w & 0xffff0000u); }
__device__ __forceinline__ float wave_sum(float v) {
#pragma unroll
    for (int o = 1; o < 64; o <<= 1) v += __shfl_xor(v, o);
    return v;
}
__device__ __forceinline__ float half_max(float m) { auto rr = __builtin_amdgcn_permlane32_swap(__float_as_uint(m), __float_as_uint(m), false, false); return fmaxf(__uint_as_float(rr[0]), __uint_as_float(rr[1])); }
__device__ __forceinline__ float half_sum(float m) { auto rr = __builtin_amdgcn_permlane32_swap(__float_as_uint(m), __float_as_uint(m), false, false); return __uint_as_float(rr[0]) + __uint_as_float(rr[1]); }
__device__ __forceinline__ int pi32(int i) { return (i & 0x13) | ((i & 8) >> 1) | ((i & 4) << 1); }
__device__ __forceinline__ float silu_f(float x) { return x * __builtin_amdgcn_rcpf(1.f + __expf(-x)); }
__device__ __forceinline__ int lane_now() { int l; asm volatile("v_mbcnt_lo_u32_b32 %0, -1, 0\n\tv_mbcnt_hi_u32_b32 %0, -1, %0" : "=v"(l)); return l; }
#define MFMA32(a, b, c) __builtin_amdgcn_mfma_f32_32x32x16_bf16((a), (b), (c), 0, 0, 0)

__device__ __forceinline__ void p0_silu_to_lds(const float* c, float* sc, int tid) {
#pragma unroll
    for (int i = 0; i < 8; ++i) { const float cb = c[tid + 512 * i]; sc[tid + 512 * i] = cb / (1.f + expf(-cb)); }
    __syncthreads();
}
__device__ __forceinline__ void p0_mod_item(const float* sc, const float* Wm, const float* bm, float* mod, int j0, float* red, int wid, int lane, int tid) {
    const int cl = lane & 31, kh = lane >> 5;
    float acc[4] = {0.f, 0.f, 0.f, 0.f};
#pragma unroll 16
    for (int i = 0; i < 64; ++i) {
        const int k = wid * 128 + 2 * i + kh; const float wv = Wm[(size_t)k * 3072 + j0 + cl];
#pragma unroll
        for (int b = 0; b < 4; ++b) acc[b] += sc[b * 1024 + k] * wv;
    }
#pragma unroll
    for (int b = 0; b < 4; ++b) acc[b] += __shfl_xor(acc[b], 32);
    if (lane < 32) {
#pragma unroll
        for (int b = 0; b < 4; ++b) red[(wid * 4 + b) * 32 + cl] = acc[b];
    }
    __syncthreads();
    if (tid < 128) { const int b = tid >> 5, c2 = tid & 31; float s = bm[j0 + c2];
#pragma unroll
        for (int w = 0; w < 8; ++w) s += red[(w * 4 + b) * 32 + c2];
        mod[b * 3072 + j0 + c2] = s; }
    __syncthreads();
}
__device__ __forceinline__ void p0_transpose_item(const float* W, int K, int N, bf16* WT, float* scr, int item, int lane, int nscale, float sc, int perm) {
    const int nblk = N / 32, kb = item / nblk, nb = item % nblk, k0 = 64 * kb, n0 = 32 * nb;
    int nd0 = n0;
    if (perm == 1) nd0 = (n0 < 2048 ? n0 : (n0 < 3072 ? n0 + 1024 : n0 - 1024));
    if (perm == 2) nd0 = (n0 < 1024 ? n0 : (n0 < 1536 ? n0 + 1792 : (n0 < 2688 ? n0 - 512 : n0 - 512)));
    const float f = (n0 < nscale) ? sc : 1.f;
#pragma unroll 8
    for (int i = 0; i < 32; ++i) { const int kk = 2 * i + (lane >> 5); scr[kk * 33 + (lane & 31)] = W[(size_t)(k0 + kk) * N + n0 + (lane & 31)] * f; }
    __builtin_amdgcn_wave_barrier();
    const int c = lane & 7;
#pragma unroll
    for (int j = 0; j < 4; ++j) { const int n = (lane >> 3) + 8 * j; const float* s = scr + (8 * c) * 33 + n;
        u32x4 o; o.x = cvtpk(s[0 * 33], s[1 * 33]); o.y = cvtpk(s[2 * 33], s[3 * 33]); o.z = cvtpk(s[4 * 33], s[5 * 33]); o.w = cvtpk(s[6 * 33], s[7 * 33]);
        *(u32x4*)(WT + (size_t)(nd0 + n) * K + k0 + 8 * c) = o; }
    __builtin_amdgcn_wave_barrier();
}

__device__ __forceinline__ void p_hrows(const float* X, bf16* H, const float* ng, const float* mod, int gw, int NGW, int lane) {
    for (int ch = gw; ch < M / 16; ch += NGW) {
        const int m0 = ch * 16, b = m0 / S; const float* mb = mod + b * 3072;
        f32x4 A[4], SH[4];
#pragma unroll
        for (int j = 0; j < 4; ++j) { const int col = 4 * lane + 256 * j; const f32x4 g = *(const f32x4*)(ng + col); const f32x4 sc = *(const f32x4*)(mb + 1024 + col); A[j] = g * (1.f + sc); SH[j] = *(const f32x4*)(mb + col); }
#pragma unroll 1
        for (int r0 = 0; r0 < 16; r0 += 4) {
            f32x4 v[4][4];
#pragma unroll
            for (int rr = 0; rr < 4; ++rr) { const float* xr = X + (size_t)(m0 + r0 + rr) * D;
#pragma unroll
                for (int j = 0; j < 4; ++j) v[rr][j] = *(const f32x4*)(xr + 4 * lane + 256 * j); }
#pragma unroll
            for (int rr = 0; rr < 4; ++rr) {
                float ss = 0.f;
#pragma unroll
                for (int j = 0; j < 4; ++j) ss += (v[rr][j].x * v[rr][j].x + v[rr][j].y * v[rr][j].y) + (v[rr][j].z * v[rr][j].z + v[rr][j].w * v[rr][j].w);
                ss = wave_sum(ss); const float rstd = 1.0f / sqrtf(ss * (1.f / D) + EPS);
                bf16* hr = H + (size_t)(m0 + r0 + rr) * D;
#pragma unroll
                for (int j = 0; j < 4; ++j) { const f32x4 o = v[rr][j] * rstd * A[j] + SH[j]; u32x2 w; w.x = cvtpk(o.x, o.y); w.y = cvtpk(o.z, o.w); *(u32x2*)(hr + 4 * lane + 256 * j) = w; }
            }
        }
    }
}

__device__ __forceinline__ void p_normrope(bf16* U, const int* pos, const float* aq, const float* ak, const float* bq, const float* bk, float* scr, int gw, int NGW, int lane) {
    const int sub = lane & 3, hsl = lane >> 2;
    const float invf = exp2f(-(float)(lane & 31) * (13.287712379549449f / 32.f));
    constexpr int NP = 1;
    int colp[NP]; float scp[NP]; bool validp[NP]; const float* gp[NP];
    { const int hs = hsl; validp[0] = hs < 10;
      if (hs < 8) { colp[0] = C_KA + 64 * hs; gp[0] = ak; scp[0] = 1.f; }
      else { colp[0] = C_KB + 64 * ((hs - 8) & 1); gp[0] = bk; scp[0] = 1.f; } }
    for (int ch = gw; ch < M / 16; ch += NGW) {
#pragma unroll 1
        for (int r0 = 0; r0 < 16; r0 += 4) {
            const int m0 = ch * 16 + r0;
            u32x4 xa[4][NP], xb[4][NP];
#pragma unroll
            for (int rr = 0; rr < 4; ++rr) { const bf16* ur = U + (size_t)(m0 + rr) * EU;
#pragma unroll
                for (int p = 0; p < NP; ++p) { xa[rr][p] = u32x4{0u, 0u, 0u, 0u}; xb[rr][p] = xa[rr][p];
                    if (validp[p]) { xa[rr][p] = *(const u32x4*)(ur + colp[p] + 8 * sub); xb[rr][p] = *(const u32x4*)(ur + colp[p] + 32 + 8 * sub); } } }
#pragma unroll
            for (int rr = 0; rr < 4; ++rr) {
                const float ang = (float)pos[m0 + rr] * invf;
                const float kq = rintf(ang * 0.15915494309189535f);
                float rd = fmaf(-kq, 6.28318548202514648f, ang); rd = fmaf(-kq, -1.74845553e-07f, rd);
                const float rv = rd * 0.15915494309189535f;
                scr[rr * 64 + lane] = (lane < 32) ? __builtin_amdgcn_cosf(rv) : __builtin_amdgcn_sinf(rv);
            }
            __builtin_amdgcn_wave_barrier();
#pragma unroll
            for (int rr = 0; rr < 4; ++rr) {
                float c8[8], s8[8];
#pragma unroll
                for (int i = 0; i < 8; ++i) { c8[i] = scr[rr * 64 + 8 * sub + i]; s8[i] = scr[rr * 64 + 32 + 8 * sub + i]; }
                bf16* ur = U + (size_t)(m0 + rr) * EU;
#pragma unroll
                for (int p = 0; p < NP; ++p) {
                    float x1[8], x2[8]; float ss = 0.f;
#pragma unroll
                    for (int i = 0; i < 4; ++i) { x1[2 * i] = bf_lo(xa[rr][p][i]); x1[2 * i + 1] = bf_hi(xa[rr][p][i]); x2[2 * i] = bf_lo(xb[rr][p][i]); x2[2 * i + 1] = bf_hi(xb[rr][p][i]); }
#pragma unroll
                    for (int i = 0; i < 8; ++i) ss += x1[i] * x1[i] + x2[i] * x2[i];
                    ss += __shfl_xor(ss, 1); ss += __shfl_xor(ss, 2);
                    const float rstd = 1.0f / sqrtf(ss * (1.f / 64.f) + EPS);
                    const float* g = gp[p]; const float sc = scp[p];
                    float o1[8], o2[8];
#pragma unroll
                    for (int i = 0; i < 8; ++i) { const float y1 = x1[i] * rstd * g[8 * sub + i], y2 = x2[i] * rstd * g[32 + 8 * sub + i];
                        o1[i] = (y1 * c8[i] - y2 * s8[i]) * sc; o2[i] = (y2 * c8[i] + y1 * s8[i]) * sc; }
                    if (validp[p]) { u32x4 wa, wb;
#pragma unroll
                        for (int i = 0; i < 4; ++i) { wa[i] = cvtpk(o1[2 * i], o1[2 * i + 1]); wb[i] = cvtpk(o2[2 * i], o2[2 * i + 1]); }
                        *(u32x4*)(ur + colp[p] + 8 * sub) = wa; *(u32x4*)(ur + colp[p] + 32 + 8 * sub) = wb; }
                }
            }
            __builtin_amdgcn_wave_barrier();
        }
    }
}

__device__ __forceinline__ void p_vt_item(const bf16* U, int ldu, int colbase, bf16* VT, int NC, int cdst0, int b, int s0, unsigned* scr, int lane) {
#pragma unroll
    for (int i = 0; i < 8; ++i) { const int row = i * 8 + (lane >> 3), ch = lane & 7;
        const u32x4 v = *(const u32x4*)(U + (size_t)(b * S + s0 + row) * ldu + colbase + 8 * ch);
        scr[row * 33 + 4 * ch + 0] = v.x; scr[row * 33 + 4 * ch + 1] = v.y; scr[row * 33 + 4 * ch + 2] = v.z; scr[row * 33 + 4 * ch + 3] = v.w; }
    __builtin_amdgcn_wave_barrier();
#pragma unroll
    for (int i = 0; i < 8; ++i) { const int c = i * 8 + (lane >> 3), ch = lane & 7; const int sh = (c & 1) * 16;
        unsigned hv[8];
#pragma unroll
        for (int k = 0; k < 8; ++k) hv[k] = (scr[(8 * ch + k) * 33 + (c >> 1)] >> sh) & 0xffffu;
        u32x4 o; o.x = hv[0] | (hv[1] << 16); o.y = hv[2] | (hv[3] << 16); o.z = hv[4] | (hv[5] << 16); o.w = hv[6] | (hv[7] << 16);
        *(u32x4*)(VT + (size_t)(b * NC + cdst0 + c) * S + s0 + 8 * ch) = o; }
    __builtin_amdgcn_wave_barrier();
}

constexpr int KROW = 144;
constexpr int KBUF_BYTES = 64 * KROW;
constexpr int VBUF128_BYTES = 128 * KROW;
constexpr int DK_BYTES = 8192, DV_BYTES = 16384;

__device__ __forceinline__ void qk_tile(f32x16& s0, f32x16& s1, const unsigned char* Kb, const bf16x8 (&qf)[4], int prow, int hi) {
    const unsigned char* k0 = Kb + prow * KROW + hi * 16;
    s0 = f32x16{}; s1 = f32x16{};
#pragma unroll
    for (int ks = 0; ks < 4; ++ks) {
        const bf16x8 a0 = *(const bf16x8*)(k0 + ks * 32), a1 = *(const bf16x8*)(k0 + 32 * KROW + ks * 32);
        s0 = MFMA32(a0, qf[ks], s0); s1 = MFMA32(a1, qf[ks], s1);
    }
}
__device__ __forceinline__ bf16x8 pack8(const f32x16& p, int base) {
    u32x4 w; w.x = cvtpk(p[base], p[base + 1]); w.y = cvtpk(p[base + 2], p[base + 3]); w.z = cvtpk(p[base + 4], p[base + 5]); w.w = cvtpk(p[base + 6], p[base + 7]);
    return __builtin_bit_cast(bf16x8, w);
}
template <int NDB>
__device__ __forceinline__ void sm_update(f32x16& s0, f32x16& s1, float& m, float& l, f32x16 (&o)[NDB], bf16x8 (&pk)[4]) {
    float mx = fmaxf(s0[0], s1[0]);
#pragma unroll
    for (int r = 1; r < 16; ++r) mx = fmaxf(mx, fmaxf(s0[r], s1[r]));
    mx = half_max(mx);
    const float mn = fmaxf(m, mx);
    if (__any(mn > m)) {
        const float f = (mn > m) ? __builtin_amdgcn_exp2f(m - mn) : 1.f;
        l *= f;
#pragma unroll
        for (int db = 0; db < NDB; ++db)
#pragma unroll
            for (int r = 0; r < 16; ++r) o[db][r] *= f;
        m = mn;
    }
    float ps = 0.f;
#pragma unroll
    for (int r = 0; r < 16; ++r) { s0[r] = __builtin_amdgcn_exp2f(s0[r] - m); s1[r] = __builtin_amdgcn_exp2f(s1[r] - m); ps += s0[r] + s1[r]; }
    l += ps;
    pk[0] = pack8(s0, 0); pk[1] = pack8(s0, 8); pk[2] = pack8(s1, 0); pk[3] = pack8(s1, 8);
}


__device__ __forceinline__ void q_norm_rope(bf16x8 (&qf)[4], const float* gain, int pos, int hi_) {
    const int hi = lane_now() >> 5; (void)hi_;
    float x[4][8]; float ss = 0.f;
#pragma unroll
    for (int ks = 0; ks < 4; ++ks) { const u32x4 w = __builtin_bit_cast(u32x4, qf[ks]);
#pragma unroll
        for (int i = 0; i < 4; ++i) { x[ks][2 * i] = bf_lo(w[i]); x[ks][2 * i + 1] = bf_hi(w[i]); } }
#pragma unroll
    for (int ks = 0; ks < 4; ++ks)
#pragma unroll
        for (int j = 0; j < 8; ++j) ss += x[ks][j] * x[ks][j];
    ss = half_sum(ss);
    const float rstd = 1.0f / sqrtf(ss * (1.f / 64.f) + EPS);
    const float fpos = (float)pos;
#pragma unroll
    for (int ks = 0; ks < 2; ++ks) {
        const f32x4 ga = *(const f32x4*)(gain + 16 * ks + 8 * hi), gb = *(const f32x4*)(gain + 16 * ks + 8 * hi + 4);
        const f32x4 gc = *(const f32x4*)(gain + 32 + 16 * ks + 8 * hi), gd = *(const f32x4*)(gain + 32 + 16 * ks + 8 * hi + 4);
#pragma unroll
        for (int j = 0; j < 8; ++j) {
            const int d = 16 * ks + 8 * hi + j;
            const float invf = exp2f(-(float)d * (13.287712379549449f / 32.f));
            const float ang = fpos * invf;
            const float kq = rintf(ang * 0.15915494309189535f);
            float rd = fmaf(-kq, 6.28318548202514648f, ang); rd = fmaf(-kq, -1.74845553e-07f, rd);
            const float rv = rd * 0.15915494309189535f;
            const float cs = __builtin_amdgcn_cosf(rv), sn = __builtin_amdgcn_sinf(rv);
            const float g1 = (j < 4) ? ga[j & 3] : gb[j & 3], g2 = (j < 4) ? gc[j & 3] : gd[j & 3];
            const float y1 = x[ks][j] * rstd * g1, y2 = x[ks + 2][j] * rstd * g2;
            x[ks][j] = (y1 * cs - y2 * sn) * QS; x[ks + 2][j] = (y2 * cs + y1 * sn) * QS;
        }
    }
#pragma unroll
    for (int ks = 0; ks < 4; ++ks) { u32x4 w;
#pragma unroll
        for (int i = 0; i < 4; ++i) w[i] = cvtpk(x[ks][2 * i], x[ks][2 * i + 1]);
        qf[ks] = __builtin_bit_cast(bf16x8, w); }
}

#define SBAR() __builtin_amdgcn_sched_barrier(0)
#define PIN(x) asm volatile("" : "+v"(x))
__device__ __forceinline__ float max3f(float a, float b, float c) { float r; asm("v_max3_f32 %0, %1, %2, %3" : "=v"(r) : "v"(a), "v"(b), "v"(c)); return r; }
template <bool FIXM> __device__ __forceinline__ void diff_unit(int b, int h, int qb, float lam, const bf16* U, const bf16* VTa, bf16* Y, const float* subg, const float* qgain, const int* pos, unsigned char* lds, int tid, int wid, int lane) {
    lane = lane_now(); tid = wid * 64 + lane;
    const int r32 = lane & 31, hi = lane >> 5, prow = pi32(r32);
    const int q0 = qb * 256, t0 = q0 + 32 * wid, tq = t0 + r32;
    const size_t rowbase = (size_t)b * S;
    const int NT = 4 * qb + 4, mylast = 4 * qb + (wid >> 1);
    f32x16 o[4];
#pragma unroll 1
    for (int c = 0; c < 2; ++c) {
        LAS unsigned char* qlds = (LAS unsigned char*)lds + 98304 + wid * 4096 + lane * 16;
        { const bf16* qp = U + (rowbase + tq) * EU + C_QA + (2 * h + c) * 64 + hi * 8; bf16x8 qraw[4];
#pragma unroll
          for (int ks = 0; ks < 4; ++ks) qraw[ks] = *(const bf16x8*)(qp + ks * 16);
          q_norm_rope(qraw, qgain, pos[rowbase + tq], hi);
#pragma unroll
          for (int ks = 0; ks < 4; ++ks) *(LAS bf16x8*)(qlds + ks * 1024) = qraw[ks]; }
#define QF(ks) (*(const LAS bf16x8*)(qlds + (ks) * 1024))
        const int srow = 8 * wid + (lane >> 3), sch = (lane & 7) ^ ((srow >> 1) & 7);
        const char* kb_u = (const char*)(U + rowbase * EU + C_KA + (2 * h + c) * 64);
        const char* vb_u = (const char*)(VTa + (size_t)(h * 128) * M + rowbase);
        const unsigned koff = (unsigned)(srow * EU + 8 * sch) * 2u, voff = (unsigned)(srow * M + 8 * sch) * 2u;
        LAS unsigned char* ldsl = (LAS unsigned char*)lds + wid * 1024;
#define DMA_K(t_, slot_) __builtin_amdgcn_global_load_lds((const unsigned*)(kb_u + (size_t)(t_) * (64 * EU * 2) + koff), (LAS unsigned*)(ldsl + (slot_) * DK_BYTES), 16, 0, 0)
#define DMA_V(t_, slot_) do { __builtin_amdgcn_global_load_lds((const unsigned*)(vb_u + (size_t)(t_) * 128 + voff), (LAS unsigned*)(ldsl + 4 * DK_BYTES + (slot_) * DV_BYTES), 16, 0, 0); \
                             __builtin_amdgcn_global_load_lds((const unsigned*)(vb_u + (size_t)(t_) * 128 + (size_t)64 * M * 2 + voff), (LAS unsigned*)(ldsl + 4 * DK_BYTES + (slot_) * DV_BYTES + 8192), 16, 0, 0); } while (0)
#define DMA_GROUP(t_) do { const int kt_ = ((t_) + 3 < NT) ? (t_) + 3 : NT - 1; int vt_ = ((t_) + 2 < NT) ? (t_) + 2 : NT - 1; vt_ = vt_ < 0 ? 0 : vt_; DMA_K(kt_, ((t_) + 3) & 3); DMA_V(vt_, ((t_) + 2) & 3); } while (0)
        DMA_GROUP(-3); DMA_GROUP(-2); DMA_GROUP(-1);
        asm volatile("s_waitcnt vmcnt(6)" ::: "memory");
        __builtin_amdgcn_s_barrier();
        float m = -INFINITY, l = 0.f;
#pragma unroll
        for (int db = 0; db < 4; ++db) o[db] = f32x16{};
        u32x4 pwA[4], pwB[4];
#pragma unroll
        for (int i = 0; i < 4; ++i) { pwA[i] = u32x4{0u, 0u, 0u, 0u}; pwB[i] = pwA[i]; }
        const LAS unsigned char* kfp = (const LAS unsigned char*)lds + prow * 128; const LAS unsigned char* vfp = (const LAS unsigned char*)lds + 4 * DK_BYTES + r32 * 128;
        unsigned kofs[4], vofs[4];
#pragma unroll
        for (int k4 = 0; k4 < 4; ++k4) { kofs[k4] = ((2 * k4 + hi) ^ ((prow >> 1) & 7)) * 16; vofs[k4] = ((2 * k4 + hi) ^ ((r32 >> 1) & 7)) * 16; }
#define KFRAG(Kb, i) (*(const LAS bf16x8*)((Kb) + ((i) & 1) * 4096 + kofs[(i) >> 1]))
#define VFRAG(Vb, j) (*(const LAS bf16x8*)((Vb) + ((j) & 3) * 4096 + vofs[(j) >> 2]))
#define DQK(T_) \
                f32x16 n0 = f32x16{}, n1 = f32x16{}; \
                { const LAS unsigned char* Kb = kfp + ((T_) & 3) * DK_BYTES; bf16x8 kf[2], qr[2]; \
                  _Pragma("unroll") for (int i = 0; i < 2; ++i) { kf[i] = KFRAG(Kb, i); qr[i] = QF(i); } \
                  SBAR(); \
                  _Pragma("unroll") for (int i = 0; i < 8; ++i) { \
                      if (i & 1) n1 = MFMA32(kf[i & 1], qr[(i >> 1) & 1], n1); else n0 = MFMA32(kf[i & 1], qr[(i >> 1) & 1], n0); \
                      if (i + 2 < 8) kf[i & 1] = KFRAG(Kb, i + 2); \
                      if ((i & 1) && (i >> 1) + 2 < 4) qr[(i >> 1) & 1] = QF((i >> 1) + 2); \
                      SBAR(); } } \
                if ((T_) == mylast) { \
                    int tqm = tq - 64 * (T_) - 8 * hi; asm volatile("" : "+v"(tqm)); \
                    _Pragma("unroll") for (int r = 0; r < 16; ++r) { const int key = 16 * (r >> 3) + (r & 7); if (key > tqm) n0[r] = -INFINITY; if (key + 32 > tqm) n1[r] = -INFINITY; } \
                } \
                bool resc = false; float mn = 0.f, f = 1.f; \
                if (!FIXM) { \
                    asm volatile("s_nop 15\n\ts_nop 7" : "+v"(n0), "+v"(n1));     \
                    float mx = max3f(n0[0], n1[0], n0[1]), mx2 = max3f(n1[1], n0[2], n1[2]); \
                    _Pragma("unroll") for (int r = 3; r < 15; r += 2) { mx = max3f(mx, n0[r], n1[r]); mx2 = max3f(mx2, n0[r + 1], n1[r + 1]); } \
                    mx = max3f(mx, n0[15], n1[15]); mx = fmaxf(mx, mx2); \
                    mx = half_max(mx); \
                    resc = __any(mx > m + 8.f); \
                    mn = resc ? fmaxf(m, mx) : m; \
                    f = (mn > m) ? __builtin_amdgcn_exp2f(m - mn) : 1.f; \
                    m = mn; } \
                float sacc = 0.f;
#define DEXP(j, PWN) { const float a0_ = ((j) < 8 ? n0[2 * ((j) & 7)] : n1[2 * ((j) & 7)]), a1_ = ((j) < 8 ? n0[2 * ((j) & 7) + 1] : n1[2 * ((j) & 7) + 1]); \
                      const float p0 = __builtin_amdgcn_exp2f(FIXM ? a0_ : a0_ - mn), p1 = __builtin_amdgcn_exp2f(FIXM ? a1_ : a1_ - mn); \
                      sacc += p0; sacc += p1; PWN[(j) >> 2][(j) & 3] = cvtpk(p0, p1); PIN(sacc); PIN(PWN[(j) >> 2]); }
#define DEND() asm volatile("s_waitcnt vmcnt(6) lgkmcnt(0)" ::: "memory"); __builtin_amdgcn_s_barrier();
#define DSTEP(T_, PWC, PWN) do { \
            DMA_GROUP(T_); \
            const LAS unsigned char* Vb = vfp + (((T_) - 1) & 3) * DV_BYTES; \
            if ((T_) <= mylast) { \
                DQK(T_) \
                bf16x8 vf[2]; \
                _Pragma("unroll") for (int j = 0; j < 2; ++j) vf[j] = VFRAG(Vb, j); \
                SBAR(); \
                _Pragma("unroll") for (int j = 0; j < 16; ++j) { \
                    o[j & 3] = MFMA32(vf[j & 1], __builtin_bit_cast(bf16x8, PWC[j >> 2]), o[j & 3]); \
                    if (j + 2 < 16) vf[j & 1] = VFRAG(Vb, j + 2); \
                    DEXP(j, PWN) \
                    SBAR(); } \
                if (resc) { l *= f; \
                    _Pragma("unroll") for (int db = 0; db < 4; ++db) _Pragma("unroll") for (int r = 0; r < 16; ++r) o[db][r] *= f; } \
                l += sacc; \
            } else if ((T_) - 1 <= mylast) { \
                _Pragma("unroll") for (int j = 0; j < 16; ++j) { const bf16x8 vf = VFRAG(Vb, j); o[j & 3] = MFMA32(vf, __builtin_bit_cast(bf16x8, PWC[j >> 2]), o[j & 3]); if ((j & 3) == 3) SBAR(); } \
            } \
            DEND() \
        } while (0)
        {
            DMA_GROUP(0);
            DQK(0)
#pragma unroll
            for (int j = 0; j < 16; ++j) DEXP(j, pwA)
            (void)resc; (void)f;
            l = sacc;
            DEND()
        }
#pragma unroll 1
        for (int t2 = 1; t2 <= NT; t2 += 2) {
            DSTEP(t2, pwA, pwB);
            if (t2 + 1 <= NT) DSTEP(t2 + 1, pwB, pwA);
        }
#undef DSTEP
#undef DQK
#undef DEXP
#undef DEND
        asm volatile("s_waitcnt vmcnt(0)" ::: "memory");
        __builtin_amdgcn_s_barrier();
#undef KFRAG
#undef VFRAG
#undef QF
#undef DMA_K
#undef DMA_V
#undef DMA_GROUP
        const float inv = 1.0f / half_sum(l);
        bf16* yst = Y + (rowbase + tq) * D + h * 128 + 4 * hi;
        if (c == 0) {
#pragma unroll
            for (int db = 0; db < 4; ++db)
#pragma unroll
                for (int g4 = 0; g4 < 4; ++g4) { u32x2 w; w.x = cvtpk(o[db][4 * g4] * inv, o[db][4 * g4 + 1] * inv); w.y = cvtpk(o[db][4 * g4 + 2] * inv, o[db][4 * g4 + 3] * inv); *(u32x2*)(yst + 32 * db + 8 * g4) = w; }
        } else {
            const float li = lam * inv;
#pragma unroll
            for (int db = 0; db < 4; ++db)
#pragma unroll
                for (int g4 = 0; g4 < 4; ++g4) { const u32x2 w = *(const u32x2*)(yst + 32 * db + 8 * g4);
                    o[db][4 * g4] = bf_lo(w.x) - o[db][4 * g4] * li; o[db][4 * g4 + 1] = bf_hi(w.x) - o[db][4 * g4 + 1] * li;
                    o[db][4 * g4 + 2] = bf_lo(w.y) - o[db][4 * g4 + 2] * li; o[db][4 * g4 + 3] = bf_hi(w.y) - o[db][4 * g4 + 3] * li; }
        }
    }
    float ss = 0.f;
#pragma unroll
    for (int db = 0; db < 4; ++db)
#pragma unroll
        for (int r = 0; r < 16; ++r) ss += o[db][r] * o[db][r];
    ss = half_sum(ss);
    const float rstd = 0.8f / sqrtf(ss * (1.f / 128.f) + EPS);
    const int lane_e = lane_now();
    const int hi_e = lane_e >> 5, tq_e = t0 + (lane_e & 31);
    const bf16* gar = U + (rowbase + tq_e) * EU + C_GA + h * 128;
    bf16* yr = Y + (rowbase + tq_e) * D + h * 128;
#pragma unroll
    for (int db = 0; db < 4; ++db)
#pragma unroll
        for (int g4 = 0; g4 < 4; ++g4) {
            const int e = 32 * db + 8 * g4 + 4 * hi_e;
            const u32x2 gw = *(const u32x2*)(gar + e); const f32x4 sg = *(const f32x4*)(subg + e);
            const float y0 = o[db][4 * g4 + 0] * rstd * sg.x * silu_f(bf_lo(gw.x)), y1 = o[db][4 * g4 + 1] * rstd * sg.y * silu_f(bf_hi(gw.x));
            const float y2 = o[db][4 * g4 + 2] * rstd * sg.z * silu_f(bf_lo(gw.y)), y3 = o[db][4 * g4 + 3] * rstd * sg.w * silu_f(bf_hi(gw.y));
            u32x2 w; w.x = cvtpk(y0, y1); w.y = cvtpk(y2, y3); *(u32x2*)(yr + e) = w;
        }
}

__device__ __forceinline__ void swa_unit(int b, int kvh, int qb, const bf16* U, const bf16* VTb, bf16* Y, const float* sinks, const float* qgain, const int* pos, unsigned char* lds, int wid, int lane) {
    const int r32 = lane & 31, hi = lane >> 5, prow = pi32(r32);
    const int q0 = qb * 256, t0 = q0 + 32 * wid, tq = t0 + r32;
    const size_t rowbase = (size_t)b * S;
    const int T0 = (q0 >= 128) ? (q0 - 128) >> 6 : 0, T1 = (q0 + 255) >> 6, nT = T1 - T0 + 1;
    {
        const int srow = 8 * wid + (lane >> 3), sch = (lane & 7) ^ ((srow >> 1) & 7);
        const char* kb_u = (const char*)(U + (rowbase + 64 * T0) * EU + C_KB + kvh * 64);
        const char* vb_u = (const char*)(VTb + ((size_t)(b * 128 + kvh * 64)) * S + 64 * T0);
        const unsigned koff = (unsigned)(srow * EU + 8 * sch) * 2u, voff = (unsigned)(srow * S + 8 * sch) * 2u;
        LAS unsigned char* ldsl = (LAS unsigned char*)lds + wid * 1024;
#pragma unroll 1
        for (int s = 0; s < nT; ++s) {
            __builtin_amdgcn_global_load_lds((const unsigned*)(kb_u + (size_t)s * (64 * EU * 2) + koff), (LAS unsigned*)(ldsl + s * 8192), 16, 0, 0);
            __builtin_amdgcn_global_load_lds((const unsigned*)(vb_u + (size_t)s * 128 + voff), (LAS unsigned*)(ldsl + 49152 + s * 8192), 16, 0, 0);
        }
        asm volatile("s_waitcnt vmcnt(0)" ::: "memory");
        __syncthreads();
    }
    const LAS unsigned char* kfp = (const LAS unsigned char*)lds + prow * 128; const LAS unsigned char* vfp = (const LAS unsigned char*)lds + 49152 + r32 * 128;
    unsigned kofs[4], vofs[4];
#pragma unroll
    for (int k4 = 0; k4 < 4; ++k4) { kofs[k4] = ((2 * k4 + hi) ^ ((prow >> 1) & 7)) * 16; vofs[k4] = ((2 * k4 + hi) ^ ((r32 >> 1) & 7)) * 16; }
    const int tlo = (t0 >= 127) ? (t0 - 127) >> 6 : 0, thi = (t0 + 31) >> 6;
#pragma unroll 1
    for (int g = 0; g < 4; ++g) {
        const int qh = kvh * 4 + g;
        bf16x8 qf[4];
        { const bf16* qp = U + (rowbase + tq) * EU + C_QB + qh * 64 + hi * 8;
#pragma unroll
          for (int ks = 0; ks < 4; ++ks) qf[ks] = *(const bf16x8*)(qp + ks * 16); }
        q_norm_rope(qf, qgain, pos[rowbase + tq], hi);
        float m = sinks[qh] * LOG2E, l = (hi == 0) ? 1.f : 0.f;
        f32x16 o[2]; o[0] = f32x16{}; o[1] = f32x16{};
#pragma unroll 1
        for (int t = tlo; t <= thi; ++t) {
            const LAS unsigned char* Kb = kfp + (t - T0) * 8192; const LAS unsigned char* Vb = vfp + (t - T0) * 8192;
            f32x16 s0 = f32x16{}, s1 = f32x16{};
#pragma unroll
            for (int ks = 0; ks < 4; ++ks) { const bf16x8 a0 = *(const LAS bf16x8*)(Kb + kofs[ks]), a1 = *(const LAS bf16x8*)(Kb + 4096 + kofs[ks]); s0 = MFMA32(a0, qf[ks], s0); s1 = MFMA32(a1, qf[ks], s1); }
            const int rel = tq - 64 * t - 8 * hi;
#pragma unroll
            for (int r = 0; r < 16; ++r) { const int key = 16 * (r >> 3) + (r & 7);
                if (key > rel || rel - key >= 128) s0[r] = -INFINITY;
                if (key + 32 > rel || rel - (key + 32) >= 128) s1[r] = -INFINITY; }
            bf16x8 pk[4]; sm_update<2>(s0, s1, m, l, o, pk);
#pragma unroll
            for (int db = 0; db < 2; ++db)
#pragma unroll
                for (int kk = 0; kk < 4; ++kk) { const bf16x8 vf = *(const LAS bf16x8*)(Vb + db * 4096 + vofs[kk]); o[db] = MFMA32(vf, pk[kk], o[db]); }
        }
        const float inv = 1.0f / half_sum(l);
        const bf16* gbr = U + (rowbase + tq) * EU + C_GB + qh * 64;
        bf16* yr = Y + (rowbase + tq) * D + 512 + qh * 64;
#pragma unroll
        for (int db = 0; db < 2; ++db)
#pragma unroll
            for (int g4 = 0; g4 < 4; ++g4) {
                const int e = 32 * db + 8 * g4 + 4 * hi;
                const u32x2 gw = *(const u32x2*)(gbr + e);
                const float y0 = o[db][4 * g4 + 0] * inv * silu_f(bf_lo(gw.x)), y1 = o[db][4 * g4 + 1] * inv * silu_f(bf_hi(gw.x));
                const float y2 = o[db][4 * g4 + 2] * inv * silu_f(bf_lo(gw.y)), y3 = o[db][4 * g4 + 3] * inv * silu_f(bf_hi(gw.y));
                u32x2 w; w.x = cvtpk(y0, y1); w.y = cvtpk(y2, y3); *(u32x2*)(yr + e) = w;
            }
    }
    __syncthreads();
}

__device__ __forceinline__ void sb_unit(int b, int h, int qb, const bf16* U, const bf16* VT, bf16* Y, unsigned char* lds, int wid, int lane, int& res_lo, int& res_hi) {
    lane = lane_now();
    const int r32 = lane & 31, hi = lane >> 5, prow = pi32(r32);
    const int q0 = qb * 256, t0 = q0 + 32 * wid, tq = t0 + r32;
    const size_t rowbase = (size_t)b * S;
    const int mytile = 4 * qb + (wid >> 1);
    bf16x8 TM[2], JN;
#pragma unroll
    for (int s2 = 0; s2 < 2; ++s2)
#pragma unroll
        for (int j = 0; j < 8; ++j) TM[s2][j] = (16 * s2 + 8 * hi + j > prow) ? (short)0xBF80 : (short)0;
#pragma unroll
    for (int j = 0; j < 8; ++j) JN[j] = (short)0xBF80;
    bf16x8 qf[4];
    { const bf16* qp = U + (rowbase + tq) * U1LD + h * 64 + hi * 8;
#pragma unroll
      for (int ks = 0; ks < 4; ++ks) qf[ks] = *(const bf16x8*)(qp + ks * 16); }
    u32x2 gwv[2][4];
    { const bf16* gr0 = U + (rowbase + tq) * U1LD + 2048 + h * 64 + 4 * hi;
#pragma unroll
      for (int db = 0; db < 2; ++db)
#pragma unroll
          for (int g4 = 0; g4 < 4; ++g4) gwv[db][g4] = *(const u32x2*)(gr0 + 32 * db + 8 * g4); }
    const int srow = 8 * wid + (lane >> 3), sch = (lane & 7) ^ ((srow >> 1) & 7);
    const char* kb_u = (const char*)(U + rowbase * U1LD + 1024 + h * 64);
    const char* vb_u = (const char*)(VT + (size_t)(h * 64) * M + rowbase);
    const unsigned koff = (unsigned)(srow * U1LD + 8 * sch) * 2u, voff = (unsigned)(srow * M + 8 * sch) * 2u;
    LAS unsigned char* ldsl = (LAS unsigned char*)lds + wid * 1024;
    const LAS unsigned char* kfp = (const LAS unsigned char*)lds + prow * 128; const LAS unsigned char* vfp = (const LAS unsigned char*)lds + 8192 + r32 * 128;
    unsigned kofs[4], vofs[4];
#pragma unroll
    for (int k4 = 0; k4 < 4; ++k4) { kofs[k4] = ((2 * k4 + hi) ^ ((prow >> 1) & 7)) * 16; vofs[k4] = ((2 * k4 + hi) ^ ((r32 >> 1) & 7)) * 16; }
    f32x16 C = f32x16{}; f32x16 o[2]; o[0] = f32x16{}; o[1] = f32x16{};
    bool alive = true;
    volatile unsigned* flg = (volatile unsigned*)(lds + LDS_MISC + 128);
#pragma unroll 1
    for (int top = 4 * qb + 3; ; top -= 7) {
        const int lo = (top >= 6) ? top - 6 : 0;
#pragma unroll 1
        for (int t = top; t >= lo; --t) {
            if (t >= res_lo && t <= res_hi) continue;
            __builtin_amdgcn_global_load_lds((const unsigned*)(kb_u + (size_t)t * (64 * U1LD * 2) + koff), (LAS unsigned*)(ldsl + (t & 7) * 16384), 16, 0, 0);
            __builtin_amdgcn_global_load_lds((const unsigned*)(vb_u + (size_t)t * 128 + voff), (LAS unsigned*)(ldsl + (t & 7) * 16384 + 8192), 16, 0, 0);
        }
        { const int nh = (res_hi < lo + 7) ? res_hi : lo + 7; res_hi = (nh > top) ? nh : top; res_lo = lo; if (res_hi > lo + 7) res_hi = lo + 7; }
        asm volatile("s_waitcnt vmcnt(0)" ::: "memory");
        __syncthreads();
#pragma unroll 1
        for (int t = (top < mytile ? top : mytile); t >= lo && alive; --t) {
            const LAS unsigned char* Kb = kfp + (t & 7) * 16384; const LAS unsigned char* Vb = vfp + (t & 7) * 16384;
            f32x16 y0 = f32x16{}, y1 = f32x16{};
#pragma unroll
            for (int ks = 0; ks < 4; ++ks) { const bf16x8 a0 = *(const LAS bf16x8*)(Kb + kofs[ks]), a1 = *(const LAS bf16x8*)(Kb + 4096 + kofs[ks]); y0 = MFMA32(a0, qf[ks], y0); y1 = MFMA32(a1, qf[ks], y1); }
#pragma unroll
            for (int r = 0; r < 16; ++r) { y0[r] = __builtin_amdgcn_fmed3f(y0[r], -3.0e38f, 100.f); y1[r] = __builtin_amdgcn_fmed3f(y1[r], -3.0e38f, 100.f); }
            if (t == mytile) {
                int tqm = tq - 64 * t - 8 * hi; asm volatile("" : "+v"(tqm));
#pragma unroll
                for (int r = 0; r < 16; ++r) { const int key = 16 * (r >> 3) + (r & 7); if (key >= tqm) y0[r] = -INFINITY; if (key + 32 >= tqm) y1[r] = -INFINITY; }
            }
            f32x16 l0, l1;
#pragma unroll
            for (int r = 0; r < 16; ++r) { l0[r] = __builtin_amdgcn_logf(1.f + __builtin_amdgcn_exp2f(y0[r])); l1[r] = __builtin_amdgcn_logf(1.f + __builtin_amdgcn_exp2f(y1[r])); }
            bf16x8 lb[4]; lb[0] = pack8(l0, 0); lb[1] = pack8(l0, 8); lb[2] = pack8(l1, 0); lb[3] = pack8(l1, 8);
#pragma unroll
            for (int r = 0; r < 16; ++r) { y0[r] -= l0[r]; y1[r] -= l1[r]; }
            f32x16 X = MFMA32(JN, lb[2], C); X = MFMA32(JN, lb[3], X);
            f32x16 f1 = MFMA32(TM[0], lb[2], C); f1 = MFMA32(TM[1], lb[3], f1);
            f32x16 f0 = MFMA32(TM[0], lb[0], X); f0 = MFMA32(TM[1], lb[1], f0);
            C = MFMA32(JN, lb[0], X); C = MFMA32(JN, lb[1], C);
#pragma unroll
            for (int r = 0; r < 16; ++r) { y0[r] = __builtin_amdgcn_exp2f(y0[r] + f0[r]); y1[r] = __builtin_amdgcn_exp2f(y1[r] + f1[r]); }
            bf16x8 pk[4]; pk[0] = pack8(y0, 0); pk[1] = pack8(y0, 8); pk[2] = pack8(y1, 0); pk[3] = pack8(y1, 8);
#pragma unroll
            for (int db = 0; db < 2; ++db)
#pragma unroll
                for (int kk = 0; kk < 4; ++kk) { const bf16x8 vf = *(const LAS bf16x8*)(Vb + db * 4096 + vofs[kk]); o[db] = MFMA32(vf, pk[kk], o[db]); }
            alive = __any(C[0] > -160.f);
        }
        if (lo == 0) break;
        if (lane == 0) flg[wid] = alive ? 1u : 0u;
        __syncthreads();
        const bool any_alive = __any(flg[lane & 7] != 0u);
        if (!any_alive) break;
        __syncthreads();
    }
    __syncthreads();
    const int lane_e = lane_now(); const int hi_e = lane_e >> 5, tq_e = t0 + (lane_e & 31);
    bf16* yr = Y + (rowbase + tq_e) * D + h * 64;
#pragma unroll
    for (int db = 0; db < 2; ++db)
#pragma unroll
        for (int g4 = 0; g4 < 4; ++g4) {
            const int e = 32 * db + 8 * g4 + 4 * hi_e;
            const u32x2 gw = gwv[db][g4];
            const float y0 = o[db][4 * g4 + 0] * silu_f(bf_lo(gw.x)), y1 = o[db][4 * g4 + 1] * silu_f(bf_hi(gw.x));
            const float y2 = o[db][4 * g4 + 2] * silu_f(bf_lo(gw.y)), y3 = o[db][4 * g4 + 3] * silu_f(bf_hi(gw.y));
            u32x2 w; w.x = cvtpk(y0, y1); w.y = cvtpk(y2, y3); *(u32x2*)(yr + e) = w;
        }
}

#define XB_TMO      128
#define XB_XCNT(j)  (256  + 64 * (j))
#define XB_XSUB(j)  (1280 + 64 * (j))
#define XB_XGEN(j)  (2304 + 64 * (j))
#define XB_TOP      3328
#define XB_TOPGEN   3392
#define XCD_BAR_WORDS 3456
#define XB_SPIN_CAP (1u << 18)

__device__ __forceinline__ unsigned xb_ld(unsigned* p)              { return __hip_atomic_load(p, __ATOMIC_RELAXED, __HIP_MEMORY_SCOPE_AGENT); }
__device__ __forceinline__ unsigned xb_add(unsigned* p, unsigned v) { return __hip_atomic_fetch_add(p, v, __ATOMIC_RELAXED, __HIP_MEMORY_SCOPE_AGENT); }
__device__ __forceinline__ unsigned xb_xcc_id() { return (unsigned)__builtin_amdgcn_s_getreg((3 << 11) | 20) & 0xFu; }
#define XB_SPIN(cond, bar) do { unsigned _sp = 0; while (cond) { __builtin_amdgcn_s_sleep(1); \
    if ((++_sp & 255u) == 0u) { if (xb_ld(&(bar)[XB_TMO])) break; if (_sp > XB_SPIN_CAP) { atomicAdd(&(bar)[XB_TMO], 1u); break; } } } } while (0)

struct XcdBarrier {
    unsigned* bar; unsigned x;
    volatile LAS unsigned* st;
};

__device__ __forceinline__ XcdBarrier xcd_barrier_post(unsigned* bar, volatile LAS unsigned* st, bool t0) {
    XcdBarrier b; b.bar = bar; b.x = xb_xcc_id(); b.st = st;
    if (t0) (void)xb_add(&bar[XB_XCNT(b.x)], 1u);
    return b;
}
__device__ __forceinline__ void xcd_barrier_complete(unsigned* bar, unsigned x, unsigned& nloc, unsigned& nx) {
    const unsigned G = gridDim.x * gridDim.y * gridDim.z;
    unsigned sum, cnt, mine, sp = 0u;
    for (;;) {
        sum = 0u; cnt = 0u; mine = 0u;
#pragma unroll
        for (unsigned j = 0; j < 16; ++j) { const unsigned c = xb_ld(&bar[XB_XCNT(j)]); sum += c; cnt += (c > 0u) ? 1u : 0u; mine = (j == x) ? c : mine; }
        if (sum == G) break;
        __builtin_amdgcn_s_sleep(1);
        if ((++sp & 255u) == 0u) { if (xb_ld(&bar[XB_TMO])) break; if (sp > XB_SPIN_CAP) { atomicAdd(&bar[XB_TMO], 1u); break; } }
    }
    nloc = mine > 0u ? mine : 1u; nx = cnt > 0u ? cnt : 1u;
}

__device__ __forceinline__ void xcd_barrier(const XcdBarrier& b, bool t0) {
    asm volatile("s_waitcnt vmcnt(0)" ::: "memory");
    __syncthreads();
    if (t0) {
        unsigned* bar = b.bar;
        __builtin_amdgcn_s_waitcnt(0);
        unsigned nloc = b.st[0], nx = b.st[1];
        if (nloc == 0u) { xcd_barrier_complete(bar, b.x, nloc, nx); b.st[0] = nloc; b.st[1] = nx; }
        const unsigned old = xb_add(&bar[XB_XSUB(b.x)], 1u);
        const unsigned gen = old / nloc;
        if (old + 1u == (gen + 1u) * nloc) {
            __builtin_amdgcn_fence(__ATOMIC_RELEASE, "agent");
            asm volatile("s_waitcnt vmcnt(0)" ::: "memory");
            const unsigned og = xb_add(&bar[XB_TOP], 1u);
            const unsigned tg = og / nx;
            if (og + 1u == (tg + 1u) * nx) xb_add(&bar[XB_TOPGEN], 1u);
            else XB_SPIN(xb_ld(&bar[XB_TOPGEN]) == tg, bar);
            __builtin_amdgcn_fence(__ATOMIC_ACQUIRE, "agent");
            xb_add(&bar[XB_XGEN(b.x)], 1u);
            asm volatile("s_waitcnt vmcnt(0)" ::: "memory");
        } else {
            XB_SPIN(xb_ld(&bar[XB_XGEN(b.x)]) == gen, bar);
            __builtin_amdgcn_fence(__ATOMIC_ACQUIRE, "agent");
            asm volatile("s_waitcnt vmcnt(0)" ::: "memory");
        }
    }
    __syncthreads();
}

#ifndef MK_SINGLE
#define MK_SINGLE 1
#endif
constexpr int NPHASE = 11;
struct Args { const float* in[23]; float* out; unsigned char* ws; int ph_lo, ph_hi; };

__global__ void __launch_bounds__(NWAVES * 64, 2) hybrid_fwd(Args args) {
    extern __shared__ __attribute__((aligned(16))) unsigned char lds[];
    const int wid = __builtin_amdgcn_readfirstlane((int)threadIdx.x >> 6);
    const int G = gridDim.x; const int bx = blockIdx.x;
    const int vcu = (G % 8 == 0) ? (bx % 8) * (G / 8) + bx / 8 : bx;
    const int gw = vcu * NWAVES + wid, NGW = G * NWAVES;
#define LANE_TID() const int lane = lane_now(); const int tid = wid * 64 + lane; (void)tid
    unsigned char* ws = args.ws;
    const float* x = args.in[0]; const float* cvec = args.in[1]; const int* pos = (const int*)args.in[2];
    float* mod_e = (float*)(ws + WS_MOD); float* mod_o = mod_e + 4 * 3072;
    bf16* WinE = (bf16*)(ws + WS_WINE); bf16* WoutE = (bf16*)(ws + WS_WOUTE); bf16* WinO = (bf16*)(ws + WS_WINO); bf16* WoutO = (bf16*)(ws + WS_WOUTO);
    bf16* H = (bf16*)(ws + WS_H); bf16* Y = H; bf16* VT = (bf16*)(ws + WS_VT); bf16* U = (bf16*)(ws + WS_U);
    bf16* VTa = VT; bf16* VTb = VT + (size_t)512 * M;
    float* scrf = (float*)(lds + LDS_SCR + wid * 8448);
    const int lo = args.ph_lo, hi_ph = args.ph_hi;
#define IN(k) (lo <= (k) && (k) < hi_ph)
#define SEAM(k) do { if (IN(k) && IN((k) + 1)) { xcd_barrier(bar, wid == 0 && lane_now() == 0); } } while (0)
    if (args.ph_lo < 0) cg::this_grid().sync();
    volatile LAS unsigned* MISC = (volatile LAS unsigned*)((LAS unsigned char*)lds + LDS_MISC);
    if (wid == 0) MISC[lane_now()] = 0u;
    __syncthreads();
    XcdBarrier bar = xcd_barrier_post((unsigned*)(ws + WS_BAR), MISC + 8, wid == 0 && lane_now() == 0);

    if (IN(0)) {
        LANE_TID();
        if (bx < 192) p0_silu_to_lds(cvec, (float*)lds + 1024, tid);
        for (int it = bx; it < 192; it += G) {
            const int l = it / 96, j0 = (it % 96) * 32;
            p0_mod_item((const float*)lds + 1024, l ? args.in[19] : args.in[4], (l ? args.in[20] : args.in[5]), l ? mod_o : mod_e, j0, (float*)lds, wid, lane, tid);
        }
        constexpr int I_INE = 16 * (EIN / 32), I_OUT = 16 * (D / 32), I_INO = 16 * (OIN / 32);
        constexpr int NITEMS = I_INE + I_OUT + I_INO + I_OUT;
        for (int it = gw; it < NITEMS; it += NGW) {
            int r = it;
            if (r < I_INE) { p0_transpose_item(args.in[6], D, EIN, WinE, scrf, r, lane, 0, 1.f, 2); continue; } r -= I_INE;
            if (r < I_OUT) { p0_transpose_item(args.in[17], D, D, WoutE, scrf, r, lane, 0, 1.f, 0); continue; } r -= I_OUT;
            if (r < I_INO) { p0_transpose_item(args.in[21], D, OIN, WinO, scrf, r, lane, 1024, QS, 1); continue; } r -= I_INO;
            p0_transpose_item(args.in[22], D, D, WoutO, scrf, r, lane, 0, 1.f, 0);
        }
    }
    SEAM(0);
    if (IN(1)) { LANE_TID(); p_hrows(x, H, args.in[3], mod_e, gw, NGW, lane); }
    SEAM(1);
    if (IN(2)) {
        { pg8::Gemm g{H, WinE, M, EU, D}; pg8::StaticOrder So; So.init(M, EU, G, bx);
          pg8::EpiStore E{U, EU};
          pg8::gemm_phase<pg8::EpiStore, pg8::StaticOrder, true, true>((PG8_LAS unsigned char*)lds, g, So, E, wid); }
        { pg8::Gemm g{WinE + (size_t)EU * D, H, 512, M, D}; pg8::StaticOrder So; So.init(512, M, G, bx);
          pg8::EpiStore E{VTa, M};
          pg8::gemm_phase<pg8::EpiStore, pg8::StaticOrder, true, true>((PG8_LAS unsigned char*)lds, g, So, E, wid); }
    }
    SEAM(2);
    if (IN(3)) {
        LANE_TID();
        p_normrope(U, pos, args.in[7], args.in[8], args.in[14], args.in[15], scrf, gw, NGW, lane);
        for (int it = gw; it < 4 * 128 * 2; it += NGW) {
            const int ct = it & 1, st = (it >> 1) & 127, b = it >> 8;
            p_vt_item(U, EU, C_VB + 64 * ct, VTb, 128, 64 * ct, b, 64 * st, (unsigned*)scrf, lane);
        }
    }
    SEAM(3);
    if (IN(4)) {
        const int lane4 = lane_now(); const int tid4 = wid * 64 + lane4;
        float lam;
        { const float p1 = args.in[9][lane4] * args.in[10][lane4], p2 = args.in[11][lane4] * args.in[12][lane4];
          lam = expf(wave_sum(p1)) - expf(wave_sum(p2)) + 0.2f; }
        bool fixm;
        { float gq = fabsf(args.in[7][lane4]), gk = fabsf(args.in[8][lane4]);
#pragma unroll
          for (int o2 = 1; o2 < 64; o2 <<= 1) { gq = fmaxf(gq, __shfl_xor(gq, o2)); gk = fmaxf(gk, __shfl_xor(gk, o2)); }
          fixm = (8.f * gq * gk * LOG2E <= 100.f); }
#ifndef NO_DIFF
        for (int p = vcu; p < 256; p += G) {
            const int bh = p >> 4, s = p & 15;
#pragma unroll 1
            for (int hf = 0; hf < 2; ++hf) {
                if (fixm) diff_unit<true>(bh >> 2, bh & 3, hf ? 31 - s : s, lam, U, VTa, Y, args.in[13], args.in[7], pos, lds, tid4, wid, lane4);
                else diff_unit<false>(bh >> 2, bh & 3, hf ? 31 - s : s, lam, U, VTa, Y, args.in[13], args.in[7], pos, lds, tid4, wid, lane4);
            }
        }
#endif
        const int lane4b = lane_now();
#ifndef NO_SWA
        for (int u = vcu; u < 256; u += G) swa_unit(u >> 6, (u >> 5) & 1, u & 31, U, VTb, Y, args.in[16], args.in[14], pos, lds, wid, lane4b);
#endif
    }
    SEAM(4);
    if (IN(5)) {
        pg8::Gemm g{Y, WoutE, M, D, D}; pg8::StaticOrder So; So.init(M, D, G, bx);
        pg8::EpiResid E{x, args.out, mod_e + 2048};
        pg8::gemm_phase<pg8::EpiResid, pg8::StaticOrder, true, true>((PG8_LAS unsigned char*)lds, g, So, E, wid);
    }
    SEAM(5);
    if (IN(6)) { LANE_TID(); p_hrows(args.out, H, args.in[18], mod_o, gw, NGW, lane); }
    SEAM(6);
    if (IN(7)) {
        { pg8::Gemm g{H, WinO, M, U1LD, D}; pg8::StaticOrder So; So.init(M, U1LD, G, bx);
          pg8::EpiStore E{U, U1LD};
          pg8::gemm_phase<pg8::EpiStore, pg8::StaticOrder, true, true>((PG8_LAS unsigned char*)lds, g, So, E, wid); }
        { pg8::Gemm g{WinO + (size_t)U1LD * D, H, 1024, M, D}; pg8::StaticOrder So; So.init(1024, M, G, bx);
          pg8::EpiStore E{VT, M};
          pg8::gemm_phase<pg8::EpiStore, pg8::StaticOrder, true, true>((PG8_LAS unsigned char*)lds, g, So, E, wid); }
    }
    SEAM(7);
    if (IN(9)) {
        const int lane9 = lane_now(); const int tid9 = wid * 64 + lane9;
        for (int run = vcu; run < 256; run += G) {
            const int bh = run >> 2; int res_lo = 1 << 30, res_hi = -1;
#pragma unroll 1
            for (int i = 7; i >= 0; --i) sb_unit(bh >> 4, bh & 15, (run & 3) * 8 + i, U, VT, Y, lds, wid, lane9, res_lo, res_hi);
        }
    }
    SEAM(9);
    if (IN(10)) {
        pg8::Gemm g{Y, WoutO, M, D, D}; pg8::StaticOrder So; So.init(M, D, G, bx);
        pg8::EpiResid E{args.out, args.out, mod_o + 2048};
        pg8::gemm_phase<pg8::EpiResid, pg8::StaticOrder, true, true>((PG8_LAS unsigned char*)lds, g, So, E, wid);
    }
#undef IN
#undef SEAM
}

extern "C" void kernel_launch(void* const* d_in, const int* in_sizes, int n_in, void* d_out, int out_size, void* d_ws, size_t ws_size, hipStream_t stream) {
    static int grid = 0;
    if (grid == 0) {
        if (n_in != 23 || out_size != M * D || ws_size < WS_END) { fprintf(stderr, "kernel_launch: unexpected shapes (n_in %d out %d ws %zu)\n", n_in, out_size, ws_size); grid = -1; return; }
        int dev = 0, cus = 0, per_cu = 0;
        hipGetDevice(&dev); hipDeviceGetAttribute(&cus, hipDeviceAttributeMultiprocessorCount, dev);
        if (hipFuncSetAttribute((const void*)hybrid_fwd, hipFuncAttributeMaxDynamicSharedMemorySize, LDS_BYTES) != hipSuccess) { fprintf(stderr, "kernel_launch: hipFuncSetAttribute failed\n"); grid = -1; return; }
        hipOccupancyMaxActiveBlocksPerMultiprocessor(&per_cu, (const void*)hybrid_fwd, NWAVES * 64, LDS_BYTES);
        (void)hipGetLastError();
        if (per_cu < 1) per_cu = 1;
        grid = cus * 1;
        if (grid <= 0) grid = 256;
    }
    if (grid < 0) return;
    if (hipMemsetAsync((char*)d_ws + WS_BAR, 0, XCD_BAR_WORDS * 4, stream) != hipSuccess) { fprintf(stderr, "kernel_launch: memset failed\n"); return; }
    Args a{};
    for (int i = 0; i < 23; ++i) a.in[i] = (const float*)d_in[i];
    a.out = (float*)d_out; a.ws = (unsigned char*)d_ws;
#if MK_SINGLE
    a.ph_lo = 0; a.ph_hi = NPHASE;
    void* kargs[] = {&a};
    hipError_t e = hipLaunchCooperativeKernel((const void*)hybrid_fwd, dim3(grid), dim3(NWAVES * 64), kargs, LDS_BYTES, stream);
    if (e != hipSuccess) fprintf(stderr, "cooperative launch failed: %s (grid %d)\n", hipGetErrorString(e), grid);
#else
    for (int ph = 0; ph < NPHASE; ++ph) {
        a.ph_lo = ph; a.ph_hi = ph + 1;
        hipLaunchKernelGGL(hybrid_fwd, dim3(grid), dim3(NWAVES * 64), LDS_BYTES, stream, a);
    }
#endif
}
```

```cpp
#include <hip/hip_runtime.h>
#include <hip/hip_cooperative_groups.h>
#include <cstdio>
#include <cstdint>
namespace cg = cooperative_groups;
namespace pg8 {
#define PG8_LAS __attribute__((address_space(3)))
typedef unsigned short bf16_t;
typedef short bf16x8 __attribute__((ext_vector_type(8)));
typedef float f32x4 __attribute__((ext_vector_type(4)));
typedef unsigned u32x4 __attribute__((ext_vector_type(4)));
constexpr int BM = 256, BK = 64, HALF = 128, HTB = HALF * BK * 2  , STAGE_BYTES = 8 * HTB, NXCD = 8, WGM = 8;

__host__ __device__ __forceinline__ int lds_byte(int r, int c) { const int st = (r >> 4) * 2 + (c >> 5), rr = r & 15, cc = c & 31, ob = rr * 64 + cc * 2; return st * 1024 + (ob ^ (((ob >> 9) & 1) << 5)); }
__host__ __device__ __forceinline__ void stage_rc(int b, int& R, int& C) { const int st = b / 1024, sb = b % 1024, swz = sb ^ (((sb >> 9) & 1) << 5); R = (st >> 1) * 16 + swz / 64; C = (st & 1) * 32 + (swz % 64) / 2; }
__host__ __device__ __forceinline__ int perm32(int rho) { const int n = rho >> 4, i = rho & 15; return 8 * (i >> 2) + 4 * n + (i & 3); }

struct Unit { int pm, pn; };
struct Gemm { const bf16_t* A; const bf16_t* Bt; int M, N, K; };

struct StaticOrder {
    int nM, nN, nwg, G, c;
    __host__ __device__ void init(int M, int N, int G_, int c_) { nM = M / BM; nN = N / BM; nwg = nM * nN; G = G_; c = c_; }
    __host__ __device__ bool next(int i, Unit& u) const {
        const long L = (long)i * G + c; if (L >= nwg) return false;
        int wgid = (int)L; { const int q = nwg / NXCD, r = nwg % NXCD, xcd = wgid % NXCD, off = wgid / NXCD; wgid = (xcd < r ? xcd * (q + 1) : r * (q + 1) + (xcd - r) * q) + off; }
        const int nig = WGM * nN, gid = wgid / nig, fm = gid * WGM, gsz = (nM - fm) < WGM ? (nM - fm) : WGM;
        u.pm = fm + ((wgid % nig) % gsz); u.pn = (wgid % nig) / gsz; return true;
    }
    __device__ __forceinline__ void a_ready(const Unit&) const {}
    __device__ __forceinline__ void done(const Unit&) const {}
};

__device__ __forceinline__ unsigned cvt_pk_bf16(float lo, float hi) { unsigned r; asm volatile("v_cvt_pk_bf16_f32 %0, %1, %2" : "=v"(r) : "v"(lo), "v"(hi)); return r; }
typedef float f32x2 __attribute__((ext_vector_type(2)));
template <class Epi, class Sched, bool ALIGN_EPI = false, bool SP2 = false>
__device__ __forceinline__ void gemm_phase(PG8_LAS unsigned char* lds, const Gemm g, const Sched& S, const Epi& E, const int wid) {
    int lane; asm volatile("v_mbcnt_lo_u32_b32 %0, -1, 0\n\tv_mbcnt_hi_u32_b32 %0, -1, %0" : "=v"(lane));
    const int tid = wid * 64 + lane, wr = wid >> 2, wc = wid & 3, fr = lane & 15, fq = lane >> 4;
    const int K = g.K, nt = K / BK;
    unsigned voffA[2], voffB[2];
#pragma unroll
    for (int i = 0; i < 2; ++i) { int R, C; stage_rc(tid * 16 + i * 8192, R, C); const int Rb = Epi::PERM ? ((R & ~31) + perm32(R & 31)) : R;
        voffA[i] = (unsigned)(R * K + C) * 2u; voffB[i] = (unsigned)(Rb * K + C) * 2u; }
    const size_t kstep = (size_t)(BK * 2);
    const size_t hstep = (size_t)HALF * K * 2;
    const size_t tstep = 2 * hstep;
    const unsigned ldsw = (unsigned)wid * 1024u;
    const int aoff = lds_byte(wr * 64 + fr, fq * 8), boff = lds_byte(wc * 32 + fr, fq * 8);
#define PG8_SA(b, h) (((b) * 2 + (h)) * HTB)
#define PG8_SB(b, h) ((4 + (b) * 2 + (h)) * HTB)
#define PG8_STAGE(bufoff, gbase, voff) do { _Pragma("unroll") for (int _i = 0; _i < 2; ++_i) \
        __builtin_amdgcn_global_load_lds((const unsigned*)((const char*)(gbase) + (voff)[_i]), (PG8_LAS unsigned*)(lds + (bufoff) + ldsw + _i * 8192), 16, 0, 0); } while (0)
#define PG8_LDA(dst, b, h) do { _Pragma("unroll") for (int m = 0; m < 4; ++m) _Pragma("unroll") for (int k = 0; k < 2; ++k) dst[m][k] = *(const PG8_LAS bf16x8*)(lds + PG8_SA(b, h) + aoff + m * 2048 + k * 1024); } while (0)
#define PG8_LDB(dst, b, h) do { _Pragma("unroll") for (int n = 0; n < 2; ++n) _Pragma("unroll") for (int k = 0; k < 2; ++k) dst[n][k] = *(const PG8_LAS bf16x8*)(lds + PG8_SB(b, h) + boff + n * 2048 + k * 1024); } while (0)
#define PG8_MMA(ai, bj, At, Bt) do { __builtin_amdgcn_s_setprio(1); _Pragma("unroll") for (int m = 0; m < 4; ++m) _Pragma("unroll") for (int n = 0; n < 2; ++n) _Pragma("unroll") for (int k = 0; k < 2; ++k) \
        acc[ai][bj][m][n] = __builtin_amdgcn_mfma_f32_16x16x32_bf16(Bt[n][k], At[m][k], acc[ai][bj][m][n], 0, 0, 0); __builtin_amdgcn_s_setprio(0); } while (0)
#define PG8_WAIT_V(n) asm volatile("s_waitcnt vmcnt(" #n ")" ::: "memory")
#define PG8_WAIT_L(n) asm volatile("s_waitcnt lgkmcnt(" #n ")" ::: "memory")
#define PG8_BAR __builtin_amdgcn_s_barrier()
#define PG8_SCHED __builtin_amdgcn_sched_barrier(0)
    Unit cur, nxt; int ui = 0;
    if (!S.next(0, cur)) return;
    f32x4 acc[2][2][4][2];
#pragma unroll
    for (int a = 0; a < 2; ++a)
#pragma unroll
        for (int b = 0; b < 2; ++b)
#pragma unroll
            for (int m = 0; m < 4; ++m)
#pragma unroll
                for (int n = 0; n < 2; ++n) acc[a][b][m][n] = (f32x4){0.f, 0.f, 0.f, 0.f};
    bf16x8 At[4][2], B0[2][2], B1[2][2];
    const char* cA = (const char*)g.A + (size_t)cur.pm * tstep; const char* cB = (const char*)g.Bt + (size_t)cur.pn * tstep;
    S.a_ready(cur);
    if constexpr (SP2) {
        PG8_STAGE(PG8_SB(0, 0), cB, voffB); PG8_STAGE(PG8_SB(0, 1), cB + hstep, voffB); PG8_STAGE(PG8_SA(0, 0), cA, voffA); PG8_STAGE(PG8_SA(0, 1), cA + hstep, voffA);
        if (wr == 1) PG8_BAR;
        PG8_WAIT_V(2); PG8_BAR;
        PG8_STAGE(PG8_SB(1, 0), cB + kstep, voffB); PG8_STAGE(PG8_SA(1, 0), cA + kstep, voffA); PG8_STAGE(PG8_SB(1, 1), cB + hstep + kstep, voffB);
        PG8_WAIT_V(6); PG8_BAR;
    } else {
        PG8_STAGE(PG8_SB(0, 0), cB, voffB); PG8_STAGE(PG8_SA(0, 0), cA, voffA); PG8_STAGE(PG8_SB(0, 1), cB + hstep, voffB); PG8_STAGE(PG8_SA(0, 1), cA + hstep, voffA);
        if (wr == 1) PG8_BAR;
        PG8_WAIT_V(4); PG8_BAR;
        PG8_STAGE(PG8_SB(1, 0), cB + kstep, voffB); PG8_STAGE(PG8_SA(1, 0), cA + kstep, voffA); PG8_STAGE(PG8_SB(1, 1), cB + hstep + kstep, voffB);
        PG8_WAIT_V(6); PG8_BAR;
    }
    for (;;) {
        const bool has_next = S.next(ui + 1, nxt);
        const char* nA = has_next ? (const char*)g.A + (size_t)nxt.pm * tstep : cA; const char* nB = has_next ? (const char*)g.Bt + (size_t)nxt.pn * tstep : cB;
        for (int t = 0; t < nt; t += 2) {
            const bool last = (t == nt - 2);
            const char* a1 = cA + (size_t)(t + 1) * kstep;
            const char* a2 = last ? nA : cA + (size_t)(t + 2) * kstep; const char* b2 = last ? nB : cB + (size_t)(t + 2) * kstep;
            const char* a3 = a2 + kstep; const char* b3 = b2 + kstep;
            if (last && has_next) S.a_ready(nxt);
            if constexpr (SP2) {
            PG8_LDB(B0, 0, 0); PG8_LDB(B1, 0, 1); PG8_SCHED; PG8_LDA(At, 0, 0); PG8_STAGE(PG8_SA(1, 1), a1 + hstep, voffA);
            PG8_WAIT_V(8); PG8_WAIT_L(0); PG8_BAR; PG8_MMA(0, 0, At, B0); PG8_MMA(0, 1, At, B1); PG8_BAR; PG8_SCHED;
            PG8_LDA(At, 0, 1); PG8_STAGE(PG8_SB(0, 0), b2, voffB); PG8_STAGE(PG8_SB(0, 1), b2 + hstep, voffB); PG8_STAGE(PG8_SA(0, 0), a2, voffA);
            PG8_WAIT_V(8); PG8_WAIT_L(0); PG8_BAR; PG8_MMA(1, 0, At, B0); PG8_MMA(1, 1, At, B1); PG8_BAR; PG8_SCHED;
            PG8_LDB(B0, 1, 0); PG8_LDB(B1, 1, 1); PG8_SCHED; PG8_LDA(At, 1, 0); PG8_STAGE(PG8_SA(0, 1), a2 + hstep, voffA);
            PG8_WAIT_V(8); PG8_WAIT_L(0); PG8_BAR; PG8_MMA(0, 0, At, B0); PG8_MMA(0, 1, At, B1); PG8_BAR; PG8_SCHED;
            PG8_LDA(At, 1, 1); PG8_STAGE(PG8_SB(1, 0), b3, voffB); PG8_STAGE(PG8_SB(1, 1), b3 + hstep, voffB); PG8_STAGE(PG8_SA(1, 0), a3, voffA);
            PG8_WAIT_V(8); PG8_WAIT_L(0); PG8_BAR; PG8_MMA(1, 0, At, B0); PG8_MMA(1, 1, At, B1); PG8_BAR; PG8_SCHED;
            } else {
            PG8_LDB(B0, 0, 0); PG8_SCHED; PG8_LDA(At, 0, 0); PG8_STAGE(PG8_SA(1, 1), a1 + hstep, voffA);
            PG8_WAIT_L(8); PG8_BAR; PG8_WAIT_L(0); PG8_MMA(0, 0, At, B0); PG8_BAR; PG8_SCHED;
            PG8_LDB(B1, 0, 1); PG8_STAGE(PG8_SB(0, 0), b2, voffB);
            PG8_BAR; PG8_WAIT_L(0); PG8_MMA(0, 1, At, B1); PG8_BAR;
            PG8_LDA(At, 0, 1); PG8_STAGE(PG8_SA(0, 0), a2, voffA);
            PG8_BAR; PG8_WAIT_L(0); PG8_MMA(1, 0, At, B0); PG8_BAR; PG8_SCHED;
            PG8_STAGE(PG8_SB(0, 1), b2 + hstep, voffB);
            PG8_WAIT_V(6); PG8_BAR; PG8_MMA(1, 1, At, B1); PG8_BAR;
            PG8_LDB(B0, 1, 0); PG8_SCHED; PG8_LDA(At, 1, 0); PG8_STAGE(PG8_SA(0, 1), a2 + hstep, voffA);
            PG8_WAIT_L(8); PG8_BAR; PG8_WAIT_L(0); PG8_MMA(0, 0, At, B0); PG8_BAR; PG8_SCHED;
            PG8_LDB(B1, 1, 1); PG8_STAGE(PG8_SB(1, 0), b3, voffB);
            PG8_BAR; PG8_WAIT_L(0); PG8_MMA(0, 1, At, B1); PG8_BAR;
            PG8_LDA(At, 1, 1); PG8_STAGE(PG8_SA(1, 0), a3, voffA);
            PG8_BAR; PG8_WAIT_L(0); PG8_MMA(1, 0, At, B0); PG8_BAR; PG8_SCHED;
            PG8_STAGE(PG8_SB(1, 1), b3 + hstep, voffB);
            PG8_WAIT_V(6); PG8_BAR; PG8_MMA(1, 1, At, B1); PG8_BAR;
            }
        }
        if constexpr (ALIGN_EPI) { if (wr == 0) PG8_BAR; }
        if constexpr (!Epi::AFTER_DRAIN) { E(acc, cur, wr, wc, fr, fq); S.done(cur); }
        if (!has_next) break;
#pragma unroll
        for (int a = 0; a < 2; ++a)
#pragma unroll
            for (int b = 0; b < 2; ++b)
#pragma unroll
                for (int m = 0; m < 4; ++m)
#pragma unroll
                    for (int n = 0; n < 2; ++n) acc[a][b][m][n] = (f32x4){0.f, 0.f, 0.f, 0.f};
        cur = nxt; cA = nA; cB = nB; ++ui;
        if constexpr (ALIGN_EPI) { if (wr == 1) PG8_BAR; }
    }
    PG8_WAIT_V(0);
    if constexpr (!ALIGN_EPI) { if (wr == 0) PG8_BAR; }
    PG8_BAR;
    if constexpr (Epi::AFTER_DRAIN) { E.fused(acc, cur, wr, wc, fr, fq, lds, wid, lane); S.done(cur); }
#undef PG8_SA
#undef PG8_SB
#undef PG8_STAGE
#undef PG8_LDA
#undef PG8_LDB
#undef PG8_MMA
#undef PG8_WAIT_V
#undef PG8_WAIT_L
#undef PG8_BAR
#undef PG8_SCHED
}
}

namespace pg8 {
struct EpiStore {
    static constexpr bool PERM = true, AFTER_DRAIN = false;
    bf16_t* O; int ldc;
    __device__ __forceinline__ void operator()(const f32x4 (&acc)[2][2][4][2], const Unit& u, int wr, int wc, int fr, int fq) const {
        const int row0 = u.pm * BM + wr * 64 + fr; const int col0 = u.pn * BM + wc * 32 + 8 * fq;
#pragma unroll
        for (int ai = 0; ai < 2; ++ai)
#pragma unroll
            for (int m = 0; m < 4; ++m) { bf16_t* rowp = O + (size_t)(row0 + ai * HALF + m * 16) * ldc + col0;
#pragma unroll
                for (int bj = 0; bj < 2; ++bj) { const f32x4 v0 = acc[ai][bj][m][0], v1 = acc[ai][bj][m][1];
                    u32x4 w; w.x = cvt_pk_bf16(v0[0], v0[1]); w.y = cvt_pk_bf16(v0[2], v0[3]); w.z = cvt_pk_bf16(v1[0], v1[1]); w.w = cvt_pk_bf16(v1[2], v1[3]);
                    *(u32x4*)(rowp + bj * HALF) = w; } }
    }
};
struct EpiResid {
    static constexpr bool PERM = false, AFTER_DRAIN = false;
    const float* base; float* out; const float* gate;
    __device__ __forceinline__ void operator()(const f32x4 (&acc)[2][2][4][2], const Unit& u, int wr, int wc, int fr, int fq) const {
        const int row0 = u.pm * BM + wr * 64 + fr; const int col0 = u.pn * BM + wc * 32 + 4 * fq;
        const float* gb = gate + (size_t)((u.pm * BM) / 8192) * 3072 + col0;
        f32x4 gv[2][2];
#pragma unroll
        for (int bj = 0; bj < 2; ++bj)
#pragma unroll
            for (int n = 0; n < 2; ++n) gv[bj][n] = *(const f32x4*)(gb + bj * HALF + n * 16);
#pragma unroll
        for (int ai = 0; ai < 2; ++ai)
#pragma unroll
            for (int m = 0; m < 4; ++m) { const size_t off = (size_t)(row0 + ai * HALF + m * 16) * 1024 + col0;
#pragma unroll
                for (int bj = 0; bj < 2; ++bj)
#pragma unroll
                    for (int n = 0; n < 2; ++n) { const f32x4 bs = *(const f32x4*)(base + off + bj * HALF + n * 16);
                        *(f32x4*)(out + off + bj * HALF + n * 16) = bs + gv[bj][n] * acc[ai][bj][m][n]; } }
    }
};
}

typedef unsigned short bf16;
typedef short bf16x8 __attribute__((ext_vector_type(8)));
typedef float f32x4 __attribute__((ext_vector_type(4)));
typedef float f32x16 __attribute__((ext_vector_type(16)));
typedef unsigned u32x4 __attribute__((ext_vector_type(4)));
typedef unsigned u32x2 __attribute__((ext_vector_type(2)));
typedef float f32x2_t __attribute__((ext_vector_type(2)));
typedef __bf16 bf16x2_t __attribute__((ext_vector_type(2)));
#define LAS __attribute__((address_space(3)))

constexpr int NB = 4, S = 8192, D = 1024, M = NB * S;
constexpr int EIN = 3328, OIN = 4096, U1LD = 3072, EU = 2816;
constexpr int C_QA = 0, C_KA = 512, C_GA = 1024, C_QB = 1536, C_KB = 2048, C_VB = 2176, C_GB = 2304;
constexpr float LOG2E = 1.4426950408889634f;
constexpr float QS = 0.125f * LOG2E;
constexpr float EPS = 1e-6f;
constexpr int NWAVES = 8;

constexpr size_t MiB = 1u << 20;
constexpr size_t WS_BAR = 0;
constexpr size_t WS_MOD = 1 * MiB;
constexpr size_t WS_WINE = 2 * MiB, WS_WOUTE = 9 * MiB, WS_WINO = 11 * MiB, WS_WOUTO = 19 * MiB;
constexpr size_t WS_H = 32 * MiB;
constexpr size_t WS_VT = 96 * MiB;
constexpr size_t WS_U = 160 * MiB;
constexpr size_t WS_END = 416 * MiB;
constexpr int LDS_BYTES = 147456;
constexpr int LDS_SCR = 65536;
constexpr int LDS_MISC = 135168;

__device__ __forceinline__ unsigned cvtpk(float lo, float hi) { f32x2_t v = {lo, hi}; bf16x2_t b = __builtin_convertvector(v, bf16x2_t); return __builtin_bit_cast(unsigned, b); }
__device__ __forceinline__ float bf_lo(unsigned w) { return __uint_as_float(w << 16); }
__device__ __forceinline__ float bf_hi(unsigned w) { return __uint_as_float(w & 0xffff0000u); }
__device__ __forceinline__ float wave_sum(float v) {
#pragma unroll
    for (int o = 1; o < 64; o <<= 1) v += __shfl_xor(v, o);
    return v;
}
__device__ __forceinline__ float half_max(float m) { auto rr = __builtin_amdgcn_permlane32_swap(__float_as_uint(m), __float_as_uint(m), false, false); return fmaxf(__uint_as_float(rr[0]), __uint_as_float(rr[1])); }
__device__ __forceinline__ float half_sum(float m) { auto rr = __builtin_amdgcn_permlane32_swap(__float_as_uint(m), __float_as_uint(m), false, false); return __uint_as_float(rr[0]) + __uint_as_float(rr[1]); }
__device__ __forceinline__ int pi32(int i) { return (i & 0x13) | ((i & 8) >> 1) | ((i & 4) << 1); }
__device__ __forceinline__ float silu_f(float x) { return x * __builtin_amdgcn_rcpf(1.f + __expf(-x)); }
__device__ __forceinline__ int lane_now() { int l; asm volatile("v_mbcnt_lo_u32_b32 %0, -1, 0\n\tv_mbcnt_hi_u32_b32 %0, -1, %0" : "=v"(l)); return l; }
#define MFMA32(a, b, c) __builtin_amdgcn_mfma_f32_32x32x16_bf16((a), (b), (c), 0, 0, 0)

__device__ __forceinline__ void p0_silu_to_lds(const float* c, float* sc, int tid) {
#pragma unroll
    for (int i = 0; i < 8; ++i) { const float cb = c[tid + 512 * i]; sc[tid + 512 * i] = cb / (1.f + expf(-cb)); }
    __syncthreads();
}
__device__ __forceinline__ void p0_mod_item(const float* sc, const float* Wm, const float* bm, float* mod, int j0, float* red, int wid, int lane, int tid) {
    const int cl = lane & 31, kh = lane >> 5;
    float acc[4] = {0.f, 0.f, 0.f, 0.f};
#pragma unroll 16
    for (int i = 0; i < 64; ++i) {
        const int k = wid * 128 + 2 * i + kh; const float wv = Wm[(size_t)k * 3072 + j0 + cl];
#pragma unroll
        for (int b = 0; b < 4; ++b) acc[b] += sc[b * 1024 + k] * wv;
    }
#pragma unroll
    for (int b = 0; b < 4; ++b) acc[b] += __shfl_xor(acc[b], 32);
    if (lane < 32) {
#pragma unroll
        for (int b = 0; b < 4; ++b) red[(wid * 4 + b) * 32 + cl] = acc[b];
    }
    __syncthreads();
    if (tid < 128) { const int b = tid >> 5, c2 = tid & 31; float s = bm[j0 + c2];
#pragma unroll
        for (int w = 0; w < 8; ++w) s += red[(w * 4 + b) * 32 + c2];
        mod[b * 3072 + j0 + c2] = s; }
    __syncthreads();
}
__device__ __forceinline__ void p0_transpose_item(const float* W, int K, int N, bf16* WT, float* scr, int item, int lane, int nscale, float sc, int perm) {
    const int nblk = N / 32, kb = item / nblk, nb = item % nblk, k0 = 64 * kb, n0 = 32 * nb;
    int nd0 = n0;
    if (perm == 1) nd0 = (n0 < 2048 ? n0 : (n0 < 3072 ? n0 + 1024 : n0 - 1024));
    if (perm == 2) nd0 = (n0 < 1024 ? n0 : (n0 < 1536 ? n0 + 1792 : (n0 < 2688 ? n0 - 512 : n0 - 512)));
    const float f = (n0 < nscale) ? sc : 1.f;
#pragma unroll 8
    for (int i = 0; i < 32; ++i) { const int kk = 2 * i + (lane >> 5); scr[kk * 33 + (lane & 31)] = W[(size_t)(k0 + kk) * N + n0 + (lane & 31)] * f; }
    __builtin_amdgcn_wave_barrier();
    const int c = lane & 7;
#pragma unroll
    for (int j = 0; j < 4; ++j) { const int n = (lane >> 3) + 8 * j; const float* s = scr + (8 * c) * 33 + n;
        u32x4 o; o.x = cvtpk(s[0 * 33], s[1 * 33]); o.y = cvtpk(s[2 * 33], s[3 * 33]); o.z = cvtpk(s[4 * 33], s[5 * 33]); o.w = cvtpk(s[6 * 33], s[7 * 33]);
        *(u32x4*)(WT + (size_t)(nd0 + n) * K + k0 + 8 * c) = o; }
    __builtin_amdgcn_wave_barrier();
}

__device__ __forceinline__ void p_hrows(const float* X, bf16* H, const float* ng, const float* mod, int gw, int NGW, int lane) {
    for (int ch = gw; ch < M / 16; ch += NGW) {
        const int m0 = ch * 16, b = m0 / S; const float* mb = mod + b * 3072;
        f32x4 A[4], SH[4];
#pragma unroll
        for (int j = 0; j < 4; ++j) { const int col = 4 * lane + 256 * j; const f32x4 g = *(const f32x4*)(ng + col); const f32x4 sc = *(const f32x4*)(mb + 1024 + col); A[j] = g * (1.f + sc); SH[j] = *(const f32x4*)(mb + col); }
#pragma unroll 1
        for (int r0 = 0; r0 < 16; r0 += 4) {
            f32x4 v[4][4];
#pragma unroll
            for (int rr = 0; rr < 4; ++rr) { const float* xr = X + (size_t)(m0 + r0 + rr) * D;
#pragma unroll
                for (int j = 0; j < 4; ++j) v[rr][j] = *(const f32x4*)(xr + 4 * lane + 256 * j); }
#pragma unroll
            for (int rr = 0; rr < 4; ++rr) {
                float ss = 0.f;
#pragma unroll
                for (int j = 0; j < 4; ++j) ss += (v[rr][j].x * v[rr][j].x + v[rr][j].y * v[rr][j].y) + (v[rr][j].z * v[rr][j].z + v[rr][j].w * v[rr][j].w);
                ss = wave_sum(ss); const float rstd = 1.0f / sqrtf(ss * (1.f / D) + EPS);
                bf16* hr = H + (size_t)(m0 + r0 + rr) * D;
#pragma unroll
                for (int j = 0; j < 4; ++j) { const f32x4 o = v[rr][j] * rstd * A[j] + SH[j]; u32x2 w; w.x = cvtpk(o.x, o.y); w.y = cvtpk(o.z, o.w); *(u32x2*)(hr + 4 * lane + 256 * j) = w; }
            }
        }
    }
}

__device__ __forceinline__ void p_normrope(bf16* U, const int* pos, const float* aq, const float* ak, const float* bq, const float* bk, float* scr, int gw, int NGW, int lane) {
    const int sub = lane & 3, hsl = lane >> 2;
    const float invf = exp2f(-(float)(lane & 31) * (13.287712379549449f / 32.f));
    constexpr int NP = 1;
    int colp[NP]; float scp[NP]; bool validp[NP]; const float* gp[NP];
    { const int hs = hsl; validp[0] = hs < 10;
      if (hs < 8) { colp[0] = C_KA + 64 * hs; gp[0] = ak; scp[0] = 1.f; }
      else { colp[0] = C_KB + 64 * ((hs - 8) & 1); gp[0] = bk; scp[0] = 1.f; } }
    for (int ch = gw; ch < M / 16; ch += NGW) {
#pragma unroll 1
        for (int r0 = 0; r0 < 16; r0 += 4) {
            const int m0 = ch * 16 + r0;
            u32x4 xa[4][NP], xb[4][NP];
#pragma unroll
            for (int rr = 0; rr < 4; ++rr) { const bf16* ur = U + (size_t)(m0 + rr) * EU;
#pragma unroll
                for (int p = 0; p < NP; ++p) { xa[rr][p] = u32x4{0u, 0u, 0u, 0u}; xb[rr][p] = xa[rr][p];
                    if (validp[p]) { xa[rr][p] = *(const u32x4*)(ur + colp[p] + 8 * sub); xb[rr][p] = *(const u32x4*)(ur + colp[p] + 32 + 8 * sub); } } }
#pragma unroll
            for (int rr = 0; rr < 4; ++rr) {
                const float ang = (float)pos[m0 + rr] * invf;
                const float kq = rintf(ang * 0.15915494309189535f);
                float rd = fmaf(-kq, 6.28318548202514648f, ang); rd = fmaf(-kq, -1.74845553e-07f, rd);
                const float rv = rd * 0.15915494309189535f;
                scr[rr * 64 + lane] = (lane < 32) ? __builtin_amdgcn_cosf(rv) : __builtin_amdgcn_sinf(rv);
            }
            __builtin_amdgcn_wave_barrier();
#pragma unroll
            for (int rr = 0; rr < 4; ++rr) {
                float c8[8], s8[8];
#pragma unroll
                for (int i = 0; i < 8; ++i) { c8[i] = scr[rr * 64 + 8 * sub + i]; s8[i] = scr[rr * 64 + 32 + 8 * sub + i]; }
                bf16* ur = U + (size_t)(m0 + rr) * EU;
#pragma unroll
                for (int p = 0; p < NP; ++p) {
                    float x1[8], x2[8]; float ss = 0.f;
#pragma unroll
                    for (int i = 0; i < 4; ++i) { x1[2 * i] = bf_lo(xa[rr][p][i]); x1[2 * i + 1] = bf_hi(xa[rr][p][i]); x2[2 * i] = bf_lo(xb[rr][p][i]); x2[2 * i + 1] = bf_hi(xb[rr][p][i]); }
#pragma unroll
                    for (int i = 0; i < 8; ++i) ss += x1[i] * x1[i] + x2[i] * x2[i];
                    ss += __shfl_xor(ss, 1); ss += __shfl_xor(ss, 2);
                    const float rstd = 1.0f / sqrtf(ss * (1.f / 64.f) + EPS);
                    const float* g = gp[p]; const float sc = scp[p];
                    float o1[8], o2[8];
#pragma unroll
                    for (int i = 0; i < 8; ++i) { const float y1 = x1[i] * rstd * g[8 * sub + i], y2 = x2[i] * rstd * g[32 + 8 * sub + i];
                        o1[i] = (y1 * c8[i] - y2 * s8[i]) * sc; o2[i] = (y2 * c8[i] + y1 * s8[i]) * sc; }
                    if (validp[p]) { u32x4 wa, wb;
#pragma unroll
                        for (int i = 0; i < 4; ++i) { wa[i] = cvtpk(o1[2 * i], o1[2 * i + 1]); wb[i] = cvtpk(o2[2 * i], o2[2 * i + 1]); }
                        *(u32x4*)(ur + colp[p] + 8 * sub) = wa; *(u32x4*)(ur + colp[p] + 32 + 8 * sub) = wb; }
                }
            }
            __builtin_amdgcn_wave_barrier();
        }
    }
}

__device__ __forceinline__ void p_vt_item(const bf16* U, int ldu, int colbase, bf16* VT, int NC, int cdst0, int b, int s0, unsigned* scr, int lane) {
#pragma unroll
    for (int i = 0; i < 8; ++i) { const int row = i * 8 + (lane >> 3), ch = lane & 7;
        const u32x4 v = *(const u32x4*)(U + (size_t)(b * S + s0 + row) * ldu + colbase + 8 * ch);
        scr[row * 33 + 4 * ch + 0] = v.x; scr[row * 33 + 4 * ch + 1] = v.y; scr[row * 33 + 4 * ch + 2] = v.z; scr[row * 33 + 4 * ch + 3] = v.w; }
    __builtin_amdgcn_wave_barrier();
#pragma unroll
    for (int i = 0; i < 8; ++i) { const int c = i * 8 + (lane >> 3), ch = lane & 7; const int sh = (c & 1) * 16;
        unsigned hv[8];
#pragma unroll
        for (int k = 0; k < 8; ++k) hv[k] = (scr[(8 * ch + k) * 33 + (c >> 1)] >> sh) & 0xffffu;
        u32x4 o; o.x = hv[0] | (hv[1] << 16); o.y = hv[2] | (hv[3] << 16); o.z = hv[4] | (hv[5] << 16); o.w = hv[6] | (hv[7] << 16);
        *(u32x4*)(VT + (size_t)(b * NC + cdst0 + c) * S + s0 + 8 * ch) = o; }
    __builtin_amdgcn_wave_barrier();
}

constexpr int KROW = 144;
constexpr int KBUF_BYTES = 64 * KROW;
constexpr int VBUF128_BYTES = 128 * KROW;
constexpr int DK_BYTES = 8192, DV_BYTES = 16384;

__device__ __forceinline__ void qk_tile(f32x16& s0, f32x16& s1, const unsigned char* Kb, const bf16x8 (&qf)[4], int prow, int hi) {
    const unsigned char* k0 = Kb + prow * KROW + hi * 16;
    s0 = f32x16{}; s1 = f32x16{};
#pragma unroll
    for (int ks = 0; ks < 4; ++ks) {
        const bf16x8 a0 = *(const bf16x8*)(k0 + ks * 32), a1 = *(const bf16x8*)(k0 + 32 * KROW + ks * 32);
        s0 = MFMA32(a0, qf[ks], s0); s1 = MFMA32(a1, qf[ks], s1);
    }
}
__device__ __forceinline__ bf16x8 pack8(const f32x16& p, int base) {
    u32x4 w; w.x = cvtpk(p[base], p[base + 1]); w.y = cvtpk(p[base + 2], p[base + 3]); w.z = cvtpk(p[base + 4], p[base + 5]); w.w = cvtpk(p[base + 6], p[base + 7]);
    return __builtin_bit_cast(bf16x8, w);
}
template <int NDB>
__device__ __forceinline__ void sm_update(f32x16& s0, f32x16& s1, float& m, float& l, f32x16 (&o)[NDB], bf16x8 (&pk)[4]) {
    float mx = fmaxf(s0[0], s1[0]);
#pragma unroll
    for (int r = 1; r < 16; ++r) mx = fmaxf(mx, fmaxf(s0[r], s1[r]));
    mx = half_max(mx);
    const float mn = fmaxf(m, mx);
    if (__any(mn > m)) {
        const float f = (mn > m) ? __builtin_amdgcn_exp2f(m - mn) : 1.f;
        l *= f;
#pragma unroll
        for (int db = 0; db < NDB; ++db)
#pragma unroll
            for (int r = 0; r < 16; ++r) o[db][r] *= f;
        m = mn;
    }
    float ps = 0.f;
#pragma unroll
    for (int r = 0; r < 16; ++r) { s0[r] = __builtin_amdgcn_exp2f(s0[r] - m); s1[r] = __builtin_amdgcn_exp2f(s1[r] - m); ps += s0[r] + s1[r]; }
    l += ps;
    pk[0] = pack8(s0, 0); pk[1] = pack8(s0, 8); pk[2] = pack8(s1, 0); pk[3] = pack8(s1, 8);
}


__device__ __forceinline__ void q_norm_rope(bf16x8 (&qf)[4], const float* gain, int pos, int hi_) {
    const int hi = lane_now() >> 5; (void)hi_;
    float x[4][8]; float ss = 0.f;
#pragma unroll
    for (int ks = 0; ks < 4; ++ks) { const u32x4 w = __builtin_bit_cast(u32x4, qf[ks]);
#pragma unroll
        for (int i = 0; i < 4; ++i) { x[ks][2 * i] = bf_lo(w[i]); x[ks][2 * i + 1] = bf_hi(w[i]); } }
#pragma unroll
    for (int ks = 0; ks < 4; ++ks)
#pragma unroll
        for (int j = 0; j < 8; ++j) ss += x[ks][j] * x[ks][j];
    ss = half_sum(ss);
    const float rstd = 1.0f / sqrtf(ss * (1.f / 64.f) + EPS);
    const float fpos = (float)pos;
#pragma unroll
    for (int ks = 0; ks < 2; ++ks) {
        const f32x4 ga = *(const f32x4*)(gain + 16 * ks + 8 * hi), gb = *(const f32x4*)(gain + 16 * ks + 8 * hi + 4);
        const f32x4 gc = *(const f32x4*)(gain + 32 + 16 * ks + 8 * hi), gd = *(const f32x4*)(gain + 32 + 16 * ks + 8 * hi + 4);
#pragma unroll
        for (int j = 0; j < 8; ++j) {
            const int d = 16 * ks + 8 * hi + j;
            const float invf = exp2f(-(float)d * (13.287712379549449f / 32.f));
            const float ang = fpos * invf;
            const float kq = rintf(ang * 0.15915494309189535f);
            float rd = fmaf(-kq, 6.28318548202514648f, ang); rd = fmaf(-kq, -1.74845553e-07f, rd);
            const float rv = rd * 0.15915494309189535f;
            const float cs = __builtin_amdgcn_cosf(rv), sn = __builtin_amdgcn_sinf(rv);
            const float g1 = (j < 4) ? ga[j & 3] : gb[j & 3], g2 = (j < 4) ? gc[j & 3] : gd[j & 3];
            const float y1 = x[ks][j] * rstd * g1, y2 = x[ks + 2][j] * rstd * g2;
            x[ks][j] = (y1 * cs - y2 * sn) * QS; x[ks + 2][j] = (y2 * cs + y1 * sn) * QS;
        }
    }
#pragma unroll
    for (int ks = 0; ks < 4; ++ks) { u32x4 w;
#pragma unroll
        for (int i = 0; i < 4; ++i) w[i] = cvtpk(x[ks][2 * i], x[ks][2 * i + 1]);
        qf[ks] = __builtin_bit_cast(bf16x8, w); }
}

#define SBAR() __builtin_amdgcn_sched_barrier(0)
#define PIN(x) asm volatile("" : "+v"(x))
__device__ __forceinline__ float max3f(float a, float b, float c) { float r; asm("v_max3_f32 %0, %1, %2, %3" : "=v"(r) : "v"(a), "v"(b), "v"(c)); return r; }
template <bool FIXM> __device__ __forceinline__ void diff_unit(int b, int h, int qb, float lam, const bf16* U, const bf16* VTa, bf16* Y, const float* subg, const float* qgain, const int* pos, unsigned char* lds, int tid, int wid, int lane) {
    lane = lane_now(); tid = wid * 64 + lane;
    const int r32 = lane & 31, hi = lane >> 5, prow = pi32(r32);
    const int q0 = qb * 256, t0 = q0 + 32 * wid, tq = t0 + r32;
    const size_t rowbase = (size_t)b * S;
    const int NT = 4 * qb + 4, mylast = 4 * qb + (wid >> 1);
    f32x16 o[4];
#pragma unroll 1
    for (int c = 0; c < 2; ++c) {
        LAS unsigned char* qlds = (LAS unsigned char*)lds + 98304 + wid * 4096 + lane * 16;
        { const bf16* qp = U + (rowbase + tq) * EU + C_QA + (2 * h + c) * 64 + hi * 8; bf16x8 qraw[4];
#pragma unroll
          for (int ks = 0; ks < 4; ++ks) qraw[ks] = *(const bf16x8*)(qp + ks * 16);
          q_norm_rope(qraw, qgain, pos[rowbase + tq], hi);
#pragma unroll
          for (int ks = 0; ks < 4; ++ks) *(LAS bf16x8*)(qlds + ks * 1024) = qraw[ks]; }
#define QF(ks) (*(const LAS bf16x8*)(qlds + (ks) * 1024))
        const int srow = 8 * wid + (lane >> 3), sch = (lane & 7) ^ ((srow >> 1) & 7);
        const char* kb_u = (const char*)(U + rowbase * EU + C_KA + (2 * h + c) * 64);
        const char* vb_u = (const char*)(VTa + (size_t)(h * 128) * M + rowbase);
        const unsigned koff = (unsigned)(srow * EU + 8 * sch) * 2u, voff = (unsigned)(srow * M + 8 * sch) * 2u;
        LAS unsigned char* ldsl = (LAS unsigned char*)lds + wid * 1024;
#define DMA_K(t_, slot_) __builtin_amdgcn_global_load_lds((const unsigned*)(kb_u + (size_t)(t_) * (64 * EU * 2) + koff), (LAS unsigned*)(ldsl + (slot_) * DK_BYTES), 16, 0, 0)
#define DMA_V(t_, slot_) do { __builtin_amdgcn_global_load_lds((const unsigned*)(vb_u + (size_t)(t_) * 128 + voff), (LAS unsigned*)(ldsl + 4 * DK_BYTES + (slot_) * DV_BYTES), 16, 0, 0); \
                             __builtin_amdgcn_global_load_lds((const unsigned*)(vb_u + (size_t)(t_) * 128 + (size_t)64 * M * 2 + voff), (LAS unsigned*)(ldsl + 4 * DK_BYTES + (slot_) * DV_BYTES + 8192), 16, 0, 0); } while (0)
#define DMA_GROUP(t_) do { const int kt_ = ((t_) + 3 < NT) ? (t_) + 3 : NT - 1; int vt_ = ((t_) + 2 < NT) ? (t_) + 2 : NT - 1; vt_ = vt_ < 0 ? 0 : vt_; DMA_K(kt_, ((t_) + 3) & 3); DMA_V(vt_, ((t_) + 2) & 3); } while (0)
        DMA_GROUP(-3); DMA_GROUP(-2); DMA_GROUP(-1);
        asm volatile("s_waitcnt vmcnt(6)" ::: "memory");
        __builtin_amdgcn_s_barrier();
        float m = -INFINITY, l = 0.f;
#pragma unroll
        for (int db = 0; db < 4; ++db) o[db] = f32x16{};
        u32x4 pwA[4], pwB[4];
#pragma unroll
        for (int i = 0; i < 4; ++i) { pwA[i] = u32x4{0u, 0u, 0u, 0u}; pwB[i] = pwA[i]; }
        const LAS unsigned char* kfp = (const LAS unsigned char*)lds + prow * 128; const LAS unsigned char* vfp = (const LAS unsigned char*)lds + 4 * DK_BYTES + r32 * 128;
        unsigned kofs[4], vofs[4];
#pragma unroll
        for (int k4 = 0; k4 < 4; ++k4) { kofs[k4] = ((2 * k4 + hi) ^ ((prow >> 1) & 7)) * 16; vofs[k4] = ((2 * k4 + hi) ^ ((r32 >> 1) & 7)) * 16; }
#define KFRAG(Kb, i) (*(const LAS bf16x8*)((Kb) + ((i) & 1) * 4096 + kofs[(i) >> 1]))
#define VFRAG(Vb, j) (*(const LAS bf16x8*)((Vb) + ((j) & 3) * 4096 + vofs[(j) >> 2]))
#define DQK(T_) \
                f32x16 n0 = f32x16{}, n1 = f32x16{}; \
                { const LAS unsigned char* Kb = kfp + ((T_) & 3) * DK_BYTES; bf16x8 kf[2], qr[2]; \
                  _Pragma("unroll") for (int i = 0; i < 2; ++i) { kf[i] = KFRAG(Kb, i); qr[i] = QF(i); } \
                  SBAR(); \
                  _Pragma("unroll") for (int i = 0; i < 8; ++i) { \
                      if (i & 1) n1 = MFMA32(kf[i & 1], qr[(i >> 1) & 1], n1); else n0 = MFMA32(kf[i & 1], qr[(i >> 1) & 1], n0); \
                      if (i + 2 < 8) kf[i & 1] = KFRAG(Kb, i + 2); \
                      if ((i & 1) && (i >> 1) + 2 < 4) qr[(i >> 1) & 1] = QF((i >> 1) + 2); \
                      SBAR(); } } \
                if ((T_) == mylast) { \
                    int tqm = tq - 64 * (T_) - 8 * hi; asm volatile("" : "+v"(tqm)); \
                    _Pragma("unroll") for (int r = 0; r < 16; ++r) { const int key = 16 * (r >> 3) + (r & 7); if (key > tqm) n0[r] = -INFINITY; if (key + 32 > tqm) n1[r] = -INFINITY; } \
                } \
                bool resc = false; float mn = 0.f, f = 1.f; \
                if (!FIXM) { \
                    asm volatile("s_nop 15\n\ts_nop 7" : "+v"(n0), "+v"(n1));     \
                    float mx = max3f(n0[0], n1[0], n0[1]), mx2 = max3f(n1[1], n0[2], n1[2]); \
                    _Pragma("unroll") for (int r = 3; r < 15; r += 2) { mx = max3f(mx, n0[r], n1[r]); mx2 = max3f(mx2, n0[r + 1], n1[r + 1]); } \
                    mx = max3f(mx, n0[15], n1[15]); mx = fmaxf(mx, mx2); \
                    mx = half_max(mx); \
                    resc = __any(mx > m + 8.f); \
                    mn = resc ? fmaxf(m, mx) : m; \
                    f = (mn > m) ? __builtin_amdgcn_exp2f(m - mn) : 1.f; \
                    m = mn; } \
                float sacc = 0.f;
#define DEXP(j, PWN) { const float a0_ = ((j) < 8 ? n0[2 * ((j) & 7)] : n1[2 * ((j) & 7)]), a1_ = ((j) < 8 ? n0[2 * ((j) & 7) + 1] : n1[2 * ((j) & 7) + 1]); \
                      const float p0 = __builtin_amdgcn_exp2f(FIXM ? a0_ : a0_ - mn), p1 = __builtin_amdgcn_exp2f(FIXM ? a1_ : a1_ - mn); \
                      sacc += p0; sacc += p1; PWN[(j) >> 2][(j) & 3] = cvtpk(p0, p1); PIN(sacc); PIN(PWN[(j) >> 2]); }
#define DEND() asm volatile("s_waitcnt vmcnt(6) lgkmcnt(0)" ::: "memory"); __builtin_amdgcn_s_barrier();
#define DSTEP(T_, PWC, PWN) do { \
            DMA_GROUP(T_); \
            const LAS unsigned char* Vb = vfp + (((T_) - 1) & 3) * DV_BYTES; \
            if ((T_) <= mylast) { \
                DQK(T_) \
                bf16x8 vf[2]; \
                _Pragma("unroll") for (int j = 0; j < 2; ++j) vf[j] = VFRAG(Vb, j); \
                SBAR(); \
                _Pragma("unroll") for (int j = 0; j < 16; ++j) { \
                    o[j & 3] = MFMA32(vf[j & 1], __builtin_bit_cast(bf16x8, PWC[j >> 2]), o[j & 3]); \
                    if (j + 2 < 16) vf[j & 1] = VFRAG(Vb, j + 2); \
                    DEXP(j, PWN) \
                    SBAR(); } \
                if (resc) { l *= f; \
                    _Pragma("unroll") for (int db = 0; db < 4; ++db) _Pragma("unroll") for (int r = 0; r < 16; ++r) o[db][r] *= f; } \
                l += sacc; \
            } else if ((T_) - 1 <= mylast) { \
                _Pragma("unroll") for (int j = 0; j < 16; ++j) { const bf16x8 vf = VFRAG(Vb, j); o[j & 3] = MFMA32(vf, __builtin_bit_cast(bf16x8, PWC[j >> 2]), o[j & 3]); if ((j & 3) == 3) SBAR(); } \
            } \
            DEND() \
        } while (0)
        {
            DMA_GROUP(0);
            DQK(0)
#pragma unroll
            for (int j = 0; j < 16; ++j) DEXP(j, pwA)
            (void)resc; (void)f;
            l = sacc;
            DEND()
        }
#pragma unroll 1
        for (int t2 = 1; t2 <= NT; t2 += 2) {
            DSTEP(t2, pwA, pwB);
            if (t2 + 1 <= NT) DSTEP(t2 + 1, pwB, pwA);
        }
#undef DSTEP
#undef DQK
#undef DEXP
#undef DEND
        asm volatile("s_waitcnt vmcnt(0)" ::: "memory");
        __builtin_amdgcn_s_barrier();
#undef KFRAG
#undef VFRAG
#undef QF
#undef DMA_K
#undef DMA_V
#undef DMA_GROUP
        const float inv = 1.0f / half_sum(l);
        bf16* yst = Y + (rowbase + tq) * D + h * 128 + 4 * hi;
        if (c == 0) {
#pragma unroll
            for (int db = 0; db < 4; ++db)
#pragma unroll
                for (int g4 = 0; g4 < 4; ++g4) { u32x2 w; w.x = cvtpk(o[db][4 * g4] * inv, o[db][4 * g4 + 1] * inv); w.y = cvtpk(o[db][4 * g4 + 2] * inv, o[db][4 * g4 + 3] * inv); *(u32x2*)(yst + 32 * db + 8 * g4) = w; }
        } else {
            const float li = lam * inv;
#pragma unroll
            for (int db = 0; db < 4; ++db)
#pragma unroll
                for (int g4 = 0; g4 < 4; ++g4) { const u32x2 w = *(const u32x2*)(yst + 32 * db + 8 * g4);
                    o[db][4 * g4] = bf_lo(w.x) - o[db][4 * g4] * li; o[db][4 * g4 + 1] = bf_hi(w.x) - o[db][4 * g4 + 1] * li;
                    o[db][4 * g4 + 2] = bf_lo(w.y) - o[db][4 * g4 + 2] * li; o[db][4 * g4 + 3] = bf_hi(w.y) - o[db][4 * g4 + 3] * li; }
        }
    }
    float ss = 0.f;
#pragma unroll
    for (int db = 0; db < 4; ++db)
#pragma unroll
        for (int r = 0; r < 16; ++r) ss += o[db][r] * o[db][r];
    ss = half_sum(ss);
    const float rstd = 0.8f / sqrtf(ss * (1.f / 128.f) + EPS);
    const int lane_e = lane_now();
    const int hi_e = lane_e >> 5, tq_e = t0 + (lane_e & 31);
    const bf16* gar = U + (rowbase + tq_e) * EU + C_GA + h * 128;
    bf16* yr = Y + (rowbase + tq_e) * D + h * 128;
#pragma unroll
    for (int db = 0; db < 4; ++db)
#pragma unroll
        for (int g4 = 0; g4 < 4; ++g4) {
            const int e = 32 * db + 8 * g4 + 4 * hi_e;
            const u32x2 gw = *(const u32x2*)(gar + e); const f32x4 sg = *(const f32x4*)(subg + e);
            const float y0 = o[db][4 * g4 + 0] * rstd * sg.x * silu_f(bf_lo(gw.x)), y1 = o[db][4 * g4 + 1] * rstd * sg.y * silu_f(bf_hi(gw.x));
            const float y2 = o[db][4 * g4 + 2] * rstd * sg.z * silu_f(bf_lo(gw.y)), y3 = o[db][4 * g4 + 3] * rstd * sg.w * silu_f(bf_hi(gw.y));
            u32x2 w; w.x = cvtpk(y0, y1); w.y = cvtpk(y2, y3); *(u32x2*)(yr + e) = w;
        }
}

__device__ __forceinline__ void swa_unit(int b, int kvh, int qb, const bf16* U, const bf16* VTb, bf16* Y, const float* sinks, const float* qgain, const int* pos, unsigned char* lds, int wid, int lane) {
    const int r32 = lane & 31, hi = lane >> 5, prow = pi32(r32);
    const int q0 = qb * 256, t0 = q0 + 32 * wid, tq = t0 + r32;
    const size_t rowbase = (size_t)b * S;
    const int T0 = (q0 >= 128) ? (q0 - 128) >> 6 : 0, T1 = (q0 + 255) >> 6, nT = T1 - T0 + 1;
    {
        const int srow = 8 * wid + (lane >> 3), sch = (lane & 7) ^ ((srow >> 1) & 7);
        const char* kb_u = (const char*)(U + (rowbase + 64 * T0) * EU + C_KB + kvh * 64);
        const char* vb_u = (const char*)(VTb + ((size_t)(b * 128 + kvh * 64)) * S + 64 * T0);
        const unsigned koff = (unsigned)(srow * EU + 8 * sch) * 2u, voff = (unsigned)(srow * S + 8 * sch) * 2u;
        LAS unsigned char* ldsl = (LAS unsigned char*)lds + wid * 1024;
#pragma unroll 1
        for (int s = 0; s < nT; ++s) {
            __builtin_amdgcn_global_load_lds((const unsigned*)(kb_u + (size_t)s * (64 * EU * 2) + koff), (LAS unsigned*)(ldsl + s * 8192), 16, 0, 0);
            __builtin_amdgcn_global_load_lds((const unsigned*)(vb_u + (size_t)s * 128 + voff), (LAS unsigned*)(ldsl + 49152 + s * 8192), 16, 0, 0);
        }
        asm volatile("s_waitcnt vmcnt(0)" ::: "memory");
        __syncthreads();
    }
    const LAS unsigned char* kfp = (const LAS unsigned char*)lds + prow * 128; const LAS unsigned char* vfp = (const LAS unsigned char*)lds + 49152 + r32 * 128;
    unsigned kofs[4], vofs[4];
#pragma unroll
    for (int k4 = 0; k4 < 4; ++k4) { kofs[k4] = ((2 * k4 + hi) ^ ((prow >> 1) & 7)) * 16; vofs[k4] = ((2 * k4 + hi) ^ ((r32 >> 1) & 7)) * 16; }
    const int tlo = (t0 >= 127) ? (t0 - 127) >> 6 : 0, thi = (t0 + 31) >> 6;
#pragma unroll 1
    for (int g = 0; g < 4; ++g) {
        const int qh = kvh * 4 + g;
        bf16x8 qf[4];
        { const bf16* qp = U + (rowbase + tq) * EU + C_QB + qh * 64 + hi * 8;
#pragma unroll
          for (int ks = 0; ks < 4; ++ks) qf[ks] = *(const bf16x8*)(qp + ks * 16); }
        q_norm_rope(qf, qgain, pos[rowbase + tq], hi);
        float m = sinks[qh] * LOG2E, l = (hi == 0) ? 1.f : 0.f;
        f32x16 o[2]; o[0] = f32x16{}; o[1] = f32x16{};
#pragma unroll 1
        for (int t = tlo; t <= thi; ++t) {
            const LAS unsigned char* Kb = kfp + (t - T0) * 8192; const LAS unsigned char* Vb = vfp + (t - T0) * 8192;
            f32x16 s0 = f32x16{}, s1 = f32x16{};
#pragma unroll
            for (int ks = 0; ks < 4; ++ks) { const bf16x8 a0 = *(const LAS bf16x8*)(Kb + kofs[ks]), a1 = *(const LAS bf16x8*)(Kb + 4096 + kofs[ks]); s0 = MFMA32(a0, qf[ks], s0); s1 = MFMA32(a1, qf[ks], s1); }
            const int rel = tq - 64 * t - 8 * hi;
#pragma unroll
            for (int r = 0; r < 16; ++r) { const int key = 16 * (r >> 3) + (r & 7);
                if (key > rel || rel - key >= 128) s0[r] = -INFINITY;
                if (key + 32 > rel || rel - (key + 32) >= 128) s1[r] = -INFINITY; }
            bf16x8 pk[4]; sm_update<2>(s0, s1, m, l, o, pk);
#pragma unroll
            for (int db = 0; db < 2; ++db)
#pragma unroll
                for (int kk = 0; kk < 4; ++kk) { const bf16x8 vf = *(const LAS bf16x8*)(Vb + db * 4096 + vofs[kk]); o[db] = MFMA32(vf, pk[kk], o[db]); }
        }
        const float inv = 1.0f / half_sum(l);
        const bf16* gbr = U + (rowbase + tq) * EU + C_GB + qh * 64;
        bf16* yr = Y + (rowbase + tq) * D + 512 + qh * 64;
#pragma unroll
        for (int db = 0; db < 2; ++db)
#pragma unroll
            for (int g4 = 0; g4 < 4; ++g4) {
                const int e = 32 * db + 8 * g4 + 4 * hi;
                const u32x2 gw = *(const u32x2*)(gbr + e);
                const float y0 = o[db][4 * g4 + 0] * inv * silu_f(bf_lo(gw.x)), y1 = o[db][4 * g4 + 1] * inv * silu_f(bf_hi(gw.x));
                const float y2 = o[db][4 * g4 + 2] * inv * silu_f(bf_lo(gw.y)), y3 = o[db][4 * g4 + 3] * inv * silu_f(bf_hi(gw.y));
                u32x2 w; w.x = cvtpk(y0, y1); w.y = cvtpk(y2, y3); *(u32x2*)(yr + e) = w;
            }
    }
    __syncthreads();
}

__device__ __forceinline__ void sb_unit(int b, int h, int qb, const bf16* U, const bf16* VT, bf16* Y, unsigned char* lds, int wid, int lane, int& res_lo, int& res_hi) {
    lane = lane_now();
    const int r32 = lane & 31, hi = lane >> 5, prow = pi32(r32);
    const int q0 = qb * 256, t0 = q0 + 32 * wid, tq = t0 + r32;
    const size_t rowbase = (size_t)b * S;
    const int mytile = 4 * qb + (wid >> 1);
    bf16x8 TM[2], JN;
#pragma unroll
    for (int s2 = 0; s2 < 2; ++s2)
#pragma unroll
        for (int j = 0; j < 8; ++j) TM[s2][j] = (16 * s2 + 8 * hi + j > prow) ? (short)0xBF80 : (short)0;
#pragma unroll
    for (int j = 0; j < 8; ++j) JN[j] = (short)0xBF80;
    bf16x8 qf[4];
    { const bf16* qp = U + (rowbase + tq) * U1LD + h * 64 + hi * 8;
#pragma unroll
      for (int ks = 0; ks < 4; ++ks) qf[ks] = *(const bf16x8*)(qp + ks * 16); }
    u32x2 gwv[2][4];
    { const bf16* gr0 = U + (rowbase + tq) * U1LD + 2048 + h * 64 + 4 * hi;
#pragma unroll
      for (int db = 0; db < 2; ++db)
#pragma unroll
          for (int g4 = 0; g4 < 4; ++g4) gwv[db][g4] = *(const u32x2*)(gr0 + 32 * db + 8 * g4); }
    const int srow = 8 * wid + (lane >> 3), sch = (lane & 7) ^ ((srow >> 1) & 7);
    const char* kb_u = (const char*)(U + rowbase * U1LD + 1024 + h * 64);
    const char* vb_u = (const char*)(VT + (size_t)(h * 64) * M + rowbase);
    const unsigned koff = (unsigned)(srow * U1LD + 8 * sch) * 2u, voff = (unsigned)(srow * M + 8 * sch) * 2u;
    LAS unsigned char* ldsl = (LAS unsigned char*)lds + wid * 1024;
    const LAS unsigned char* kfp = (const LAS unsigned char*)lds + prow * 128; const LAS unsigned char* vfp = (const LAS unsigned char*)lds + 8192 + r32 * 128;
    unsigned kofs[4], vofs[4];
#pragma unroll
    for (int k4 = 0; k4 < 4; ++k4) { kofs[k4] = ((2 * k4 + hi) ^ ((prow >> 1) & 7)) * 16; vofs[k4] = ((2 * k4 + hi) ^ ((r32 >> 1) & 7)) * 16; }
    f32x16 C = f32x16{}; f32x16 o[2]; o[0] = f32x16{}; o[1] = f32x16{};
    bool alive = true;
    volatile unsigned* flg = (volatile unsigned*)(lds + LDS_MISC + 128);
#pragma unroll 1
    for (int top = 4 * qb + 3; ; top -= 7) {
        const int lo = (top >= 6) ? top - 6 : 0;
#pragma unroll 1
        for (int t = top; t >= lo; --t) {
            if (t >= res_lo && t <= res_hi) continue;
            __builtin_amdgcn_global_load_lds((const unsigned*)(kb_u + (size_t)t * (64 * U1LD * 2) + koff), (LAS unsigned*)(ldsl + (t & 7) * 16384), 16, 0, 0);
            __builtin_amdgcn_global_load_lds((const unsigned*)(vb_u + (size_t)t * 128 + voff), (LAS unsigned*)(ldsl + (t & 7) * 16384 + 8192), 16, 0, 0);
        }
        { const int nh = (res_hi < lo + 7) ? res_hi : lo + 7; res_hi = (nh > top) ? nh : top; res_lo = lo; if (res_hi > lo + 7) res_hi = lo + 7; }
        asm volatile("s_waitcnt vmcnt(0)" ::: "memory");
        __syncthreads();
#pragma unroll 1
        for (int t = (top < mytile ? top : mytile); t >= lo && alive; --t) {
            const LAS unsigned char* Kb = kfp + (t & 7) * 16384; const LAS unsigned char* Vb = vfp + (t & 7) * 16384;
#pragma unroll 1
            for (int th = 1; th >= 0 && alive; --th) {
                if (t == mytile && th == 1 && (wid & 1) == 0) continue;
                f32x16 y = f32x16{};
#pragma unroll
                for (int ks = 0; ks < 4; ++ks) { const bf16x8 a = *(const LAS bf16x8*)(Kb + th * 4096 + kofs[ks]); y = MFMA32(a, qf[ks], y); }
#pragma unroll
                for (int r = 0; r < 16; ++r) y[r] = __builtin_amdgcn_fmed3f(y[r], -3.0e38f, 100.f);
                if (t == mytile) {
                    int tqm = tq - 64 * t - 32 * th - 8 * hi; asm volatile("" : "+v"(tqm));
#pragma unroll
                    for (int r = 0; r < 16; ++r) { const int key = 16 * (r >> 3) + (r & 7); if (key >= tqm) y[r] = -INFINITY; }
                }
                f32x16 lg;
#pragma unroll
                for (int r = 0; r < 16; ++r) lg[r] = __builtin_amdgcn_logf(1.f + __builtin_amdgcn_exp2f(y[r]));
                bf16x8 lb[2]; lb[0] = pack8(lg, 0); lb[1] = pack8(lg, 8);
#pragma unroll
                for (int r = 0; r < 16; ++r) y[r] -= lg[r];
                f32x16 sf = MFMA32(TM[0], lb[0], C); sf = MFMA32(TM[1], lb[1], sf);
                C = MFMA32(JN, lb[0], C); C = MFMA32(JN, lb[1], C);
#pragma unroll
                for (int r = 0; r < 16; ++r) y[r] = __builtin_amdgcn_exp2f(y[r] + sf[r]);
                bf16x8 pk[2]; pk[0] = pack8(y, 0); pk[1] = pack8(y, 8);
#pragma unroll
                for (int db = 0; db < 2; ++db)
#pragma unroll
                    for (int k2 = 0; k2 < 2; ++k2) { const bf16x8 vf = *(const LAS bf16x8*)(Vb + db * 4096 + (th ? vofs[2 + k2] : vofs[k2])); o[db] = MFMA32(vf, pk[k2], o[db]); }
                alive = __any(C[0] > -160.f);
            }
        }
        if (lo == 0) break;
        if (lane == 0) flg[wid] = alive ? 1u : 0u;
        __syncthreads();
        const bool any_alive = __any(flg[lane & 7] != 0u);
        if (!any_alive) break;
        __syncthreads();
    }
    __syncthreads();
    const int lane_e = lane_now(); const int hi_e = lane_e >> 5, tq_e = t0 + (lane_e & 31);
    bf16* yr = Y + (rowbase + tq_e) * D + h * 64;
#pragma unroll
    for (int db = 0; db < 2; ++db)
#pragma unroll
        for (int g4 = 0; g4 < 4; ++g4) {
            const int e = 32 * db + 8 * g4 + 4 * hi_e;
            const u32x2 gw = gwv[db][g4];
            const float y0 = o[db][4 * g4 + 0] * silu_f(bf_lo(gw.x)), y1 = o[db][4 * g4 + 1] * silu_f(bf_hi(gw.x));
            const float y2 = o[db][4 * g4 + 2] * silu_f(bf_lo(gw.y)), y3 = o[db][4 * g4 + 3] * silu_f(bf_hi(gw.y));
            u32x2 w; w.x = cvtpk(y0, y1); w.y = cvtpk(y2, y3); *(u32x2*)(yr + e) = w;
        }
}

#define XB_TMO      128
#define XB_XCNT(j)  (256  + 64 * (j))
#define XB_XSUB(j)  (1280 + 64 * (j))
#define XB_XGEN(j)  (2304 + 64 * (j))
#define XB_TOP      3328
#define XB_TOPGEN   3392
#define XCD_BAR_WORDS 3456
#define XB_SPIN_CAP (1u << 18)

__device__ __forceinline__ unsigned xb_ld(unsigned* p)              { return __hip_atomic_load(p, __ATOMIC_RELAXED, __HIP_MEMORY_SCOPE_AGENT); }
__device__ __forceinline__ unsigned xb_add(unsigned* p, unsigned v) { return __hip_atomic_fetch_add(p, v, __ATOMIC_RELAXED, __HIP_MEMORY_SCOPE_AGENT); }
__device__ __forceinline__ unsigned xb_xcc_id() { return (unsigned)__builtin_amdgcn_s_getreg((3 << 11) | 20) & 0xFu; }
#define XB_SPIN(cond, bar) do { unsigned _sp = 0; while (cond) { __builtin_amdgcn_s_sleep(1); \
    if ((++_sp & 255u) == 0u) { if (xb_ld(&(bar)[XB_TMO])) break; if (_sp > XB_SPIN_CAP) { atomicAdd(&(bar)[XB_TMO], 1u); break; } } } } while (0)

struct XcdBarrier {
    unsigned* bar; unsigned x;
    volatile LAS unsigned* st;
};

__device__ __forceinline__ XcdBarrier xcd_barrier_post(unsigned* bar, volatile LAS unsigned* st, bool t0) {
    XcdBarrier b; b.bar = bar; b.x = xb_xcc_id(); b.st = st;
    if (t0) (void)xb_add(&bar[XB_XCNT(b.x)], 1u);
    return b;
}
__device__ __forceinline__ void xcd_barrier_complete(unsigned* bar, unsigned x, unsigned& nloc, unsigned& nx) {
    const unsigned G = gridDim.x * gridDim.y * gridDim.z;
    unsigned sum, cnt, mine, sp = 0u;
    for (;;) {
        sum = 0u; cnt = 0u; mine = 0u;
#pragma unroll
        for (unsigned j = 0; j < 16; ++j) { const unsigned c = xb_ld(&bar[XB_XCNT(j)]); sum += c; cnt += (c > 0u) ? 1u : 0u; mine = (j == x) ? c : mine; }
        if (sum == G) break;
        __builtin_amdgcn_s_sleep(1);
        if ((++sp & 255u) == 0u) { if (xb_ld(&bar[XB_TMO])) break; if (sp > XB_SPIN_CAP) { atomicAdd(&bar[XB_TMO], 1u); break; } }
    }
    nloc = mine > 0u ? mine : 1u; nx = cnt > 0u ? cnt : 1u;
}

__device__ __forceinline__ void xcd_barrier(const XcdBarrier& b, bool t0) {
    asm volatile("s_waitcnt vmcnt(0)" ::: "memory");
    __syncthreads();
    if (t0) {
        unsigned* bar = b.bar;
        __builtin_amdgcn_s_waitcnt(0);
        unsigned nloc = b.st[0], nx = b.st[1];
        if (nloc == 0u) { xcd_barrier_complete(bar, b.x, nloc, nx); b.st[0] = nloc; b.st[1] = nx; }
        const unsigned old = xb_add(&bar[XB_XSUB(b.x)], 1u);
        const unsigned gen = old / nloc;
        if (old + 1u == (gen + 1u) * nloc) {
            __builtin_amdgcn_fence(__ATOMIC_RELEASE, "agent");
            asm volatile("s_waitcnt vmcnt(0)" ::: "memory");
            const unsigned og = xb_add(&bar[XB_TOP], 1u);
            const unsigned tg = og / nx;
            if (og + 1u == (tg + 1u) * nx) xb_add(&bar[XB_TOPGEN], 1u);
            else XB_SPIN(xb_ld(&bar[XB_TOPGEN]) == tg, bar);
            __builtin_amdgcn_fence(__ATOMIC_ACQUIRE, "agent");
            xb_add(&bar[XB_XGEN(b.x)], 1u);
            asm volatile("s_waitcnt vmcnt(0)" ::: "memory");
        } else {
            XB_SPIN(xb_ld(&bar[XB_XGEN(b.x)]) == gen, bar);
            __builtin_amdgcn_fence(__ATOMIC_ACQUIRE, "agent");
            asm volatile("s_waitcnt vmcnt(0)" ::: "memory");
        }
    }
    __syncthreads();
}

#ifndef MK_SINGLE
#define MK_SINGLE 1
#endif
constexpr int NPHASE = 11;
struct Args { const float* in[23]; float* out; unsigned char* ws; int ph_lo, ph_hi; };

__global__ void __launch_bounds__(NWAVES * 64, 2) hybrid_fwd(Args args) {
    extern __shared__ __attribute__((aligned(16))) unsigned char lds[];
    const int wid = __builtin_amdgcn_readfirstlane((int)threadIdx.x >> 6);
    const int G = gridDim.x; const int bx = blockIdx.x;
    const int vcu = (G % 8 == 0) ? (bx % 8) * (G / 8) + bx / 8 : bx;
    const int gw = vcu * NWAVES + wid, NGW = G * NWAVES;
#define LANE_TID() const int lane = lane_now(); const int tid = wid * 64 + lane; (void)tid
    unsigned char* ws = args.ws;
    const float* x = args.in[0]; const float* cvec = args.in[1]; const int* pos = (const int*)args.in[2];
    float* mod_e = (float*)(ws + WS_MOD); float* mod_o = mod_e + 4 * 3072;
    bf16* WinE = (bf16*)(ws + WS_WINE); bf16* WoutE = (bf16*)(ws + WS_WOUTE); bf16* WinO = (bf16*)(ws + WS_WINO); bf16* WoutO = (bf16*)(ws + WS_WOUTO);
    bf16* H = (bf16*)(ws + WS_H); bf16* Y = H; bf16* VT = (bf16*)(ws + WS_VT); bf16* U = (bf16*)(ws + WS_U);
    bf16* VTa = VT; bf16* VTb = VT + (size_t)512 * M;
    float* scrf = (float*)(lds + LDS_SCR + wid * 8448);
    const int lo = args.ph_lo, hi_ph = args.ph_hi;
#define IN(k) (lo <= (k) && (k) < hi_ph)
#define SEAM(k) do { if (IN(k) && IN((k) + 1)) { xcd_barrier(bar, wid == 0 && lane_now() == 0); } } while (0)
    if (args.ph_lo < 0) cg::this_grid().sync();
    volatile LAS unsigned* MISC = (volatile LAS unsigned*)((LAS unsigned char*)lds + LDS_MISC);
    if (wid == 0) MISC[lane_now()] = 0u;
    __syncthreads();
    XcdBarrier bar = xcd_barrier_post((unsigned*)(ws + WS_BAR), MISC + 8, wid == 0 && lane_now() == 0);

    if (IN(0)) {
        LANE_TID();
        if (bx < 192) p0_silu_to_lds(cvec, (float*)lds + 1024, tid);
        for (int it = bx; it < 192; it += G) {
            const int l = it / 96, j0 = (it % 96) * 32;
            p0_mod_item((const float*)lds + 1024, l ? args.in[19] : args.in[4], (l ? args.in[20] : args.in[5]), l ? mod_o : mod_e, j0, (float*)lds, wid, lane, tid);
        }
        constexpr int I_INE = 16 * (EIN / 32), I_OUT = 16 * (D / 32), I_INO = 16 * (OIN / 32);
        constexpr int NITEMS = I_INE + I_OUT + I_INO + I_OUT;
        for (int it = gw; it < NITEMS; it += NGW) {
            int r = it;
            if (r < I_INE) { p0_transpose_item(args.in[6], D, EIN, WinE, scrf, r, lane, 0, 1.f, 2); continue; } r -= I_INE;
            if (r < I_OUT) { p0_transpose_item(args.in[17], D, D, WoutE, scrf, r, lane, 0, 1.f, 0); continue; } r -= I_OUT;
            if (r < I_INO) { p0_transpose_item(args.in[21], D, OIN, WinO, scrf, r, lane, 1024, QS, 1); continue; } r -= I_INO;
            p0_transpose_item(args.in[22], D, D, WoutO, scrf, r, lane, 0, 1.f, 0);
        }
    }
    SEAM(0);
    if (IN(1)) { LANE_TID(); p_hrows(x, H, args.in[3], mod_e, gw, NGW, lane); }
    SEAM(1);
    if (IN(2)) {
        { pg8::Gemm g{H, WinE, M, EU, D}; pg8::StaticOrder So; So.init(M, EU, G, bx);
          pg8::EpiStore E{U, EU};
          pg8::gemm_phase<pg8::EpiStore, pg8::StaticOrder, true, true>((PG8_LAS unsigned char*)lds, g, So, E, wid); }
        { pg8::Gemm g{WinE + (size_t)EU * D, H, 512, M, D}; pg8::StaticOrder So; So.init(512, M, G, bx);
          pg8::EpiStore E{VTa, M};
          pg8::gemm_phase<pg8::EpiStore, pg8::StaticOrder, true, true>((PG8_LAS unsigned char*)lds, g, So, E, wid); }
    }
    SEAM(2);
    if (IN(3)) {
        LANE_TID();
        p_normrope(U, pos, args.in[7], args.in[8], args.in[14], args.in[15], scrf, gw, NGW, lane);
        for (int it = gw; it < 4 * 128 * 2; it += NGW) {
            const int ct = it & 1, st = (it >> 1) & 127, b = it >> 8;
            p_vt_item(U, EU, C_VB + 64 * ct, VTb, 128, 64 * ct, b, 64 * st, (unsigned*)scrf, lane);
        }
    }
    SEAM(3);
    if (IN(4)) {
        const int lane4 = lane_now(); const int tid4 = wid * 64 + lane4;
        float lam;
        { const float p1 = args.in[9][lane4] * args.in[10][lane4], p2 = args.in[11][lane4] * args.in[12][lane4];
          lam = expf(wave_sum(p1)) - expf(wave_sum(p2)) + 0.2f; }
        bool fixm;
        { float gq = fabsf(args.in[7][lane4]), gk = fabsf(args.in[8][lane4]);
#pragma unroll
          for (int o2 = 1; o2 < 64; o2 <<= 1) { gq = fmaxf(gq, __shfl_xor(gq, o2)); gk = fmaxf(gk, __shfl_xor(gk, o2)); }
          fixm = (8.f * gq * gk * LOG2E <= 100.f); }
#ifndef NO_DIFF
        for (int p = vcu; p < 256; p += G) {
            const int bh = p >> 4, s = p & 15;
#pragma unroll 1
            for (int hf = 0; hf < 2; ++hf) {
                if (fixm) diff_unit<true>(bh >> 2, bh & 3, hf ? 31 - s : s, lam, U, VTa, Y, args.in[13], args.in[7], pos, lds, tid4, wid, lane4);
                else diff_unit<false>(bh >> 2, bh & 3, hf ? 31 - s : s, lam, U, VTa, Y, args.in[13], args.in[7], pos, lds, tid4, wid, lane4);
            }
        }
#endif
        const int lane4b = lane_now();
#ifndef NO_SWA
        for (int u = vcu; u < 256; u += G) swa_unit(u >> 6, (u >> 5) & 1, u & 31, U, VTb, Y, args.in[16], args.in[14], pos, lds, wid, lane4b);
#endif
    }
    SEAM(4);
    if (IN(5)) {
        pg8::Gemm g{Y, WoutE, M, D, D}; pg8::StaticOrder So; So.init(M, D, G, bx);
        pg8::EpiResid E{x, args.out, mod_e + 2048};
        pg8::gemm_phase<pg8::EpiResid, pg8::StaticOrder, true, true>((PG8_LAS unsigned char*)lds, g, So, E, wid);
    }
    SEAM(5);
    if (IN(6)) { LANE_TID(); p_hrows(args.out, H, args.in[18], mod_o, gw, NGW, lane); }
    SEAM(6);
    if (IN(7)) {
        { pg8::Gemm g{H, WinO, M, U1LD, D}; pg8::StaticOrder So; So.init(M, U1LD, G, bx);
          pg8::EpiStore E{U, U1LD};
          pg8::gemm_phase<pg8::EpiStore, pg8::StaticOrder, true, true>((PG8_LAS unsigned char*)lds, g, So, E, wid); }
        { pg8::Gemm g{WinO + (size_t)U1LD * D, H, 1024, M, D}; pg8::StaticOrder So; So.init(1024, M, G, bx);
          pg8::EpiStore E{VT, M};
          pg8::gemm_phase<pg8::EpiStore, pg8::StaticOrder, true, true>((PG8_LAS unsigned char*)lds, g, So, E, wid); }
    }
    SEAM(7);
    if (IN(9)) {
        const int lane9 = lane_now(); const int tid9 = wid * 64 + lane9;
        for (int run = vcu; run < 256; run += G) {
            const int bh = run >> 2; int res_lo = 1 << 30, res_hi = -1;
#pragma unroll 1
            for (int i = 7; i >= 0; --i) sb_unit(bh >> 4, bh & 15, (run & 3) * 8 + i, U, VT, Y, lds, wid, lane9, res_lo, res_hi);
        }
    }
    SEAM(9);
    if (IN(10)) {
        pg8::Gemm g{Y, WoutO, M, D, D}; pg8::StaticOrder So; So.init(M, D, G, bx);
        pg8::EpiResid E{args.out, args.out, mod_o + 2048};
        pg8::gemm_phase<pg8::EpiResid, pg8::StaticOrder, true, true>((PG8_LAS unsigned char*)lds, g, So, E, wid);
    }
#undef IN
#undef SEAM
}

extern "C" void kernel_launch(void* const* d_in, const int* in_sizes, int n_in, void* d_out, int out_size, void* d_ws, size_t ws_size, hipStream_t stream) {
    static int grid = 0;
    if (grid == 0) {
        if (n_in != 23 || out_size != M * D || ws_size < WS_END) { fprintf(stderr, "kernel_launch: unexpected shapes (n_in %d out %d ws %zu)\n", n_in, out_size, ws_size); grid = -1; return; }
        int dev = 0, cus = 0, per_cu = 0;
        hipGetDevice(&dev); hipDeviceGetAttribute(&cus, hipDeviceAttributeMultiprocessorCount, dev);
        if (hipFuncSetAttribute((const void*)hybrid_fwd, hipFuncAttributeMaxDynamicSharedMemorySize, LDS_BYTES) != hipSuccess) { fprintf(stderr, "kernel_launch: hipFuncSetAttribute failed\n"); grid = -1; return; }
        hipOccupancyMaxActiveBlocksPerMultiprocessor(&per_cu, (const void*)hybrid_fwd, NWAVES * 64, LDS_BYTES);
        (void)hipGetLastError();
        if (per_cu < 1) per_cu = 1;
        grid = cus * 1;
        if (grid <= 0) grid = 256;
    }
    if (grid < 0) return;
    if (hipMemsetAsync((char*)d_ws + WS_BAR, 0, XCD_BAR_WORDS * 4, stream) != hipSuccess) { fprintf(stderr, "kernel_launch: memset failed\n"); return; }
    Args a{};
    for (int i = 0; i < 23; ++i) a.in[i] = (const float*)d_in[i];
    a.out = (float*)d_out; a.ws = (unsigned char*)d_ws;
#if MK_SINGLE
    a.ph_lo = 0; a.ph_hi = NPHASE;
    void* kargs[] = {&a};
    hipError_t e = hipLaunchCooperativeKernel((const void*)hybrid_fwd, dim3(grid), dim3(NWAVES * 64), kargs, LDS_BYTES, stream);
    if (e != hipSuccess) fprintf(stderr, "cooperative launch failed: %s (grid %d)\n", hipGetErrorString(e), grid);
#else
    for (int ph = 0; ph < NPHASE; ++ph) {
        a.ph_lo = ph; a.ph_hi = ph + 1;
        hipLaunchKernelGGL(hybrid_fwd, dim3(grid), dim3(NWAVES * 64), LDS_BYTES, stream, a);
    }
#endif
}
```

```cpp
#include <hip/hip_runtime.h>
#include <hip/hip_cooperative_groups.h>
#include <cstdio>
#include <cstdint>
namespace cg = cooperative_groups;
namespace pg8 {
#define PG8_LAS __attribute__((address_space(3)))
typedef unsigned short bf16_t;
typedef short bf16x8 __attribute__((ext_vector_type(8)));
typedef float f32x4 __attribute__((ext_vector_type(4)));
typedef unsigned u32x4 __attribute__((ext_vector_type(4)));
constexpr int BM = 256, BK = 64, HALF = 128, HTB = HALF * BK * 2  , STAGE_BYTES = 8 * HTB, NXCD = 8, WGM = 8;

__host__ __device__ __forceinline__ int lds_byte(int r, int c) { const int st = (r >> 4) * 2 + (c >> 5), rr = r & 15, cc = c & 31, ob = rr * 64 + cc * 2; return st * 1024 + (ob ^ (((ob >> 9) & 1) << 5)); }
__host__ __device__ __forceinline__ void stage_rc(int b, int& R, int& C) { const int st = b / 1024, sb = b % 1024, swz = sb ^ (((sb >> 9) & 1) << 5); R = (st >> 1) * 16 + swz / 64; C = (st & 1) * 32 + (swz % 64) / 2; }
__host__ __device__ __forceinline__ int perm32(int rho) { const int n = rho >> 4, i = rho & 15; return 8 * (i >> 2) + 4 * n + (i & 3); }

struct Unit { int pm, pn; };
struct Gemm { const bf16_t* A; const bf16_t* Bt; int M, N, K; };

struct StaticOrder {
    int nM, nN, nwg, G, c;
    __host__ __device__ void init(int M, int N, int G_, int c_) { nM = M / BM; nN = N / BM; nwg = nM * nN; G = G_; c = c_; }
    __host__ __device__ bool next(int i, Unit& u) const {
        const long L = (long)i * G + c; if (L >= nwg) return false;
        int wgid = (int)L; { const int q = nwg / NXCD, r = nwg % NXCD, xcd = wgid % NXCD, off = wgid / NXCD; wgid = (xcd < r ? xcd * (q + 1) : r * (q + 1) + (xcd - r) * q) + off; }
        const int nig = WGM * nN, gid = wgid / nig, fm = gid * WGM, gsz = (nM - fm) < WGM ? (nM - fm) : WGM;
        u.pm = fm + ((wgid % nig) % gsz); u.pn = (wgid % nig) / gsz; return true;
    }
    __device__ __forceinline__ void a_ready(const Unit&) const {}
    __device__ __forceinline__ void done(const Unit&) const {}
};

__device__ __forceinline__ unsigned cvt_pk_bf16(float lo, float hi) { unsigned r; asm volatile("v_cvt_pk_bf16_f32 %0, %1, %2" : "=v"(r) : "v"(lo), "v"(hi)); return r; }
typedef float f32x2 __attribute__((ext_vector_type(2)));
template <class Epi, class Sched, bool ALIGN_EPI = false, bool SP2 = false>
__device__ __forceinline__ void gemm_phase(PG8_LAS unsigned char* lds, const Gemm g, const Sched& S, const Epi& E, const int wid) {
    int lane; asm volatile("v_mbcnt_lo_u32_b32 %0, -1, 0\n\tv_mbcnt_hi_u32_b32 %0, -1, %0" : "=v"(lane));
    const int tid = wid * 64 + lane, wr = wid >> 2, wc = wid & 3, fr = lane & 15, fq = lane >> 4;
    const int K = g.K, nt = K / BK;
    unsigned voffA[2], voffB[2];
#pragma unroll
    for (int i = 0; i < 2; ++i) { int R, C; stage_rc(tid * 16 + i * 8192, R, C); const int Rb = Epi::PERM ? ((R & ~31) + perm32(R & 31)) : R;
        voffA[i] = (unsigned)(R * K + C) * 2u; voffB[i] = (unsigned)(Rb * K + C) * 2u; }
    const size_t kstep = (size_t)(BK * 2);
    const size_t hstep = (size_t)HALF * K * 2;
    const size_t tstep = 2 * hstep;
    const unsigned ldsw = (unsigned)wid * 1024u;
    const int aoff = lds_byte(wr * 64 + fr, fq * 8), boff = lds_byte(wc * 32 + fr, fq * 8);
#define PG8_SA(b, h) (((b) * 2 + (h)) * HTB)
#define PG8_SB(b, h) ((4 + (b) * 2 + (h)) * HTB)
#define PG8_STAGE(bufoff, gbase, voff) do { _Pragma("unroll") for (int _i = 0; _i < 2; ++_i) \
        __builtin_amdgcn_global_load_lds((const unsigned*)((const char*)(gbase) + (voff)[_i]), (PG8_LAS unsigned*)(lds + (bufoff) + ldsw + _i * 8192), 16, 0, 0); } while (0)
#define PG8_LDA(dst, b, h) do { _Pragma("unroll") for (int m = 0; m < 4; ++m) _Pragma("unroll") for (int k = 0; k < 2; ++k) dst[m][k] = *(const PG8_LAS bf16x8*)(lds + PG8_SA(b, h) + aoff + m * 2048 + k * 1024); } while (0)
#define PG8_LDB(dst, b, h) do { _Pragma("unroll") for (int n = 0; n < 2; ++n) _Pragma("unroll") for (int k = 0; k < 2; ++k) dst[n][k] = *(const PG8_LAS bf16x8*)(lds + PG8_SB(b, h) + boff + n * 2048 + k * 1024); } while (0)
#define PG8_MMA(ai, bj, At, Bt) do { __builtin_amdgcn_s_setprio(1); _Pragma("unroll") for (int m = 0; m < 4; ++m) _Pragma("unroll") for (int n = 0; n < 2; ++n) _Pragma("unroll") for (int k = 0; k < 2; ++k) \
        acc[ai][bj][m][n] = __builtin_amdgcn_mfma_f32_16x16x32_bf16(Bt[n][k], At[m][k], acc[ai][bj][m][n], 0, 0, 0); __builtin_amdgcn_s_setprio(0); } while (0)
#define PG8_WAIT_V(n) asm volatile("s_waitcnt vmcnt(" #n ")" ::: "memory")
#define PG8_WAIT_L(n) asm volatile("s_waitcnt lgkmcnt(" #n ")" ::: "memory")
#define PG8_BAR __builtin_amdgcn_s_barrier()
#define PG8_SCHED __builtin_amdgcn_sched_barrier(0)
    Unit cur, nxt; int ui = 0;
    if (!S.next(0, cur)) return;
    f32x4 acc[2][2][4][2];
#pragma unroll
    for (int a = 0; a < 2; ++a)
#pragma unroll
        for (int b = 0; b < 2; ++b)
#pragma unroll
            for (int m = 0; m < 4; ++m)
#pragma unroll
                for (int n = 0; n < 2; ++n) acc[a][b][m][n] = (f32x4){0.f, 0.f, 0.f, 0.f};
    bf16x8 At[4][2], B0[2][2], B1[2][2];
    const char* cA = (const char*)g.A + (size_t)cur.pm * tstep; const char* cB = (const char*)g.Bt + (size_t)cur.pn * tstep;
    S.a_ready(cur);
    if constexpr (SP2) {
        PG8_STAGE(PG8_SB(0, 0), cB, voffB); PG8_STAGE(PG8_SB(0, 1), cB + hstep, voffB); PG8_STAGE(PG8_SA(0, 0), cA, voffA); PG8_STAGE(PG8_SA(0, 1), cA + hstep, voffA);
        if (wr == 1) PG8_BAR;
        PG8_WAIT_V(2); PG8_BAR;
        PG8_STAGE(PG8_SB(1, 0), cB + kstep, voffB); PG8_STAGE(PG8_SA(1, 0), cA + kstep, voffA); PG8_STAGE(PG8_SB(1, 1), cB + hstep + kstep, voffB);
        PG8_WAIT_V(6); PG8_BAR;
    } else {
        PG8_STAGE(PG8_SB(0, 0), cB, voffB); PG8_STAGE(PG8_SA(0, 0), cA, voffA); PG8_STAGE(PG8_SB(0, 1), cB + hstep, voffB); PG8_STAGE(PG8_SA(0, 1), cA + hstep, voffA);
        if (wr == 1) PG8_BAR;
        PG8_WAIT_V(4); PG8_BAR;
        PG8_STAGE(PG8_SB(1, 0), cB + kstep, voffB); PG8_STAGE(PG8_SA(1, 0), cA + kstep, voffA); PG8_STAGE(PG8_SB(1, 1), cB + hstep + kstep, voffB);
        PG8_WAIT_V(6); PG8_BAR;
    }
    for (;;) {
        const bool has_next = S.next(ui + 1, nxt);
        const char* nA = has_next ? (const char*)g.A + (size_t)nxt.pm * tstep : cA; const char* nB = has_next ? (const char*)g.Bt + (size_t)nxt.pn * tstep : cB;
        for (int t = 0; t < nt; t += 2) {
            const bool last = (t == nt - 2);
            const char* a1 = cA + (size_t)(t + 1) * kstep;
            const char* a2 = last ? nA : cA + (size_t)(t + 2) * kstep; const char* b2 = last ? nB : cB + (size_t)(t + 2) * kstep;
            const char* a3 = a2 + kstep; const char* b3 = b2 + kstep;
            if (last && has_next) S.a_ready(nxt);
            if constexpr (SP2) {
            PG8_LDB(B0, 0, 0); PG8_LDB(B1, 0, 1); PG8_SCHED; PG8_LDA(At, 0, 0); PG8_STAGE(PG8_SA(1, 1), a1 + hstep, voffA);
            PG8_WAIT_V(8); PG8_WAIT_L(0); PG8_BAR; PG8_MMA(0, 0, At, B0); PG8_MMA(0, 1, At, B1); PG8_BAR; PG8_SCHED;
            PG8_LDA(At, 0, 1); PG8_STAGE(PG8_SB(0, 0), b2, voffB); PG8_STAGE(PG8_SB(0, 1), b2 + hstep, voffB); PG8_STAGE(PG8_SA(0, 0), a2, voffA);
            PG8_WAIT_V(8); PG8_WAIT_L(0); PG8_BAR; PG8_MMA(1, 0, At, B0); PG8_MMA(1, 1, At, B1); PG8_BAR; PG8_SCHED;
            PG8_LDB(B0, 1, 0); PG8_LDB(B1, 1, 1); PG8_SCHED; PG8_LDA(At, 1, 0); PG8_STAGE(PG8_SA(0, 1), a2 + hstep, voffA);
            PG8_WAIT_V(8); PG8_WAIT_L(0); PG8_BAR; PG8_MMA(0, 0, At, B0); PG8_MMA(0, 1, At, B1); PG8_BAR; PG8_SCHED;
            PG8_LDA(At, 1, 1); PG8_STAGE(PG8_SB(1, 0), b3, voffB); PG8_STAGE(PG8_SB(1, 1), b3 + hstep, voffB); PG8_STAGE(PG8_SA(1, 0), a3, voffA);
            PG8_WAIT_V(8); PG8_WAIT_L(0); PG8_BAR; PG8_MMA(1, 0, At, B0); PG8_MMA(1, 1, At, B1); PG8_BAR; PG8_SCHED;
            } else {
            PG8_LDB(B0, 0, 0); PG8_SCHED; PG8_LDA(At, 0, 0); PG8_STAGE(PG8_SA(1, 1), a1 + hstep, voffA);
            PG8_WAIT_L(8); PG8_BAR; PG8_WAIT_L(0); PG8_MMA(0, 0, At, B0); PG8_BAR; PG8_SCHED;
            PG8_LDB(B1, 0, 1); PG8_STAGE(PG8_SB(0, 0), b2, voffB);
            PG8_BAR; PG8_WAIT_L(0); PG8_MMA(0, 1, At, B1); PG8_BAR;
            PG8_LDA(At, 0, 1); PG8_STAGE(PG8_SA(0, 0), a2, voffA);
            PG8_BAR; PG8_WAIT_L(0); PG8_MMA(1, 0, At, B0); PG8_BAR; PG8_SCHED;
            PG8_STAGE(PG8_SB(0, 1), b2 + hstep, voffB);
            PG8_WAIT_V(6); PG8_BAR; PG8_MMA(1, 1, At, B1); PG8_BAR;
            PG8_LDB(B0, 1, 0); PG8_SCHED; PG8_LDA(At, 1, 0); PG8_STAGE(PG8_SA(0, 1), a2 + hstep, voffA);
            PG8_WAIT_L(8); PG8_BAR; PG8_WAIT_L(0); PG8_MMA(0, 0, At, B0); PG8_BAR; PG8_SCHED;
            PG8_LDB(B1, 1, 1); PG8_STAGE(PG8_SB(1, 0), b3, voffB);
            PG8_BAR; PG8_WAIT_L(0); PG8_MMA(0, 1, At, B1); PG8_BAR;
            PG8_LDA(At, 1, 1); PG8_STAGE(PG8_SA(1, 0), a3, voffA);
            PG8_BAR; PG8_WAIT_L(0); PG8_MMA(1, 0, At, B0); PG8_BAR; PG8_SCHED;
            PG8_STAGE(PG8_SB(1, 1), b3 + hstep, voffB);
            PG8_WAIT_V(6); PG8_BAR; PG8_MMA(1, 1, At, B1); PG8_BAR;
            }
        }
        if constexpr (ALIGN_EPI) { if (wr == 0) PG8_BAR; }
        if constexpr (!Epi::AFTER_DRAIN) { E(acc, cur, wr, wc, fr, fq); S.done(cur); }
        if (!has_next) break;
#pragma unroll
        for (int a = 0; a < 2; ++a)
#pragma unroll
            for (int b = 0; b < 2; ++b)
#pragma unroll
                for (int m = 0; m < 4; ++m)
#pragma unroll
                    for (int n = 0; n < 2; ++n) acc[a][b][m][n] = (f32x4){0.f, 0.f, 0.f, 0.f};
        cur = nxt; cA = nA; cB = nB; ++ui;
        if constexpr (ALIGN_EPI) { if (wr == 1) PG8_BAR; }
    }
    PG8_WAIT_V(0);
    if constexpr (!ALIGN_EPI) { if (wr == 0) PG8_BAR; }
    PG8_BAR;
    if constexpr (Epi::AFTER_DRAIN) { E.fused(acc, cur, wr, wc, fr, fq, lds, wid, lane); S.done(cur); }
#undef PG8_SA
#undef PG8_SB
#undef PG8_STAGE
#undef PG8_LDA
#undef PG8_LDB
#undef PG8_MMA
#undef PG8_WAIT_V
#undef PG8_WAIT_L
#undef PG8_BAR
#undef PG8_SCHED
}
}

namespace pg8 {
struct EpiStore {
    static constexpr bool PERM = true, AFTER_DRAIN = false;
    bf16_t* O; int ldc;
    __device__ __forceinline__ void operator()(const f32x4 (&acc)[2][2][4][2], const Unit& u, int wr, int wc, int fr, int fq) const {
        const int row0 = u.pm * BM + wr * 64 + fr; const int col0 = u.pn * BM + wc * 32 + 8 * fq;
#pragma unroll
        for (int ai = 0; ai < 2; ++ai)
#pragma unroll
            for (int m = 0; m < 4; ++m) { bf16_t* rowp = O + (size_t)(row0 + ai * HALF + m * 16) * ldc + col0;
#pragma unroll
                for (int bj = 0; bj < 2; ++bj) { const f32x4 v0 = acc[ai][bj][m][0], v1 = acc[ai][bj][m][1];
                    u32x4 w; w.x = cvt_pk_bf16(v0[0], v0[1]); w.y = cvt_pk_bf16(v0[2], v0[3]); w.z = cvt_pk_bf16(v1[0], v1[1]); w.w = cvt_pk_bf16(v1[2], v1[3]);
                    *(u32x4*)(rowp + bj * HALF) = w; } }
    }
};
struct EpiResid {
    static constexpr bool PERM = false, AFTER_DRAIN = false;
    const float* base; float* out; const float* gate;
    __device__ __forceinline__ void operator()(const f32x4 (&acc)[2][2][4][2], const Unit& u, int wr, int wc, int fr, int fq) const {
        const int row0 = u.pm * BM + wr * 64 + fr; const int col0 = u.pn * BM + wc * 32 + 4 * fq;
        const float* gb = gate + (size_t)((u.pm * BM) / 8192) * 3072 + col0;
        f32x4 gv[2][2];
#pragma unroll
        for (int bj = 0; bj < 2; ++bj)
#pragma unroll
            for (int n = 0; n < 2; ++n) gv[bj][n] = *(const f32x4*)(gb + bj * HALF + n * 16);
#pragma unroll
        for (int ai = 0; ai < 2; ++ai)
#pragma unroll
            for (int m = 0; m < 4; ++m) { const size_t off = (size_t)(row0 + ai * HALF + m * 16) * 1024 + col0;
#pragma unroll
                for (int bj = 0; bj < 2; ++bj)
#pragma unroll
                    for (int n = 0; n < 2; ++n) { const f32x4 bs = *(const f32x4*)(base + off + bj * HALF + n * 16);
                        *(f32x4*)(out + off + bj * HALF + n * 16) = bs + gv[bj][n] * acc[ai][bj][m][n]; } }
    }
};
}

typedef unsigned short bf16;
typedef short bf16x8 __attribute__((ext_vector_type(8)));
typedef float f32x4 __attribute__((ext_vector_type(4)));
typedef float f32x16 __attribute__((ext_vector_type(16)));
typedef unsigned u32x4 __attribute__((ext_vector_type(4)));
typedef unsigned u32x2 __attribute__((ext_vector_type(2)));
typedef float f32x2_t __attribute__((ext_vector_type(2)));
typedef __bf16 bf16x2_t __attribute__((ext_vector_type(2)));
#define LAS __attribute__((address_space(3)))

constexpr int NB = 4, S = 8192, D = 1024, M = NB * S;
constexpr int EIN = 3328, OIN = 4096, U1LD = 3072, EU = 2816;
constexpr int C_QA = 0, C_KA = 512, C_GA = 1024, C_QB = 1536, C_KB = 2048, C_VB = 2176, C_GB = 2304;
constexpr float LOG2E = 1.4426950408889634f;
constexpr float QS = 0.125f * LOG2E;
constexpr float EPS = 1e-6f;
constexpr int NWAVES = 8;

constexpr size_t MiB = 1u << 20;
constexpr size_t WS_BAR = 0;
constexpr size_t WS_MOD = 1 * MiB;
constexpr size_t WS_WINE = 2 * MiB, WS_WOUTE = 9 * MiB, WS_WINO = 11 * MiB, WS_WOUTO = 19 * MiB;
constexpr size_t WS_H = 32 * MiB;
constexpr size_t WS_VT = 96 * MiB;
constexpr size_t WS_U = 160 * MiB;
constexpr size_t WS_END = 416 * MiB;
constexpr int LDS_BYTES = 147456;
constexpr int LDS_SCR = 65536;
constexpr int LDS_MISC = 135168;

__device__ __forceinline__ unsigned cvtpk(float lo, float hi) { f32x2_t v = {lo, hi}; bf16x2_t b = __builtin_convertvector(v, bf16x2_t); return __builtin_bit_cast(unsigned, b); }
__device__ __forceinline__ float bf_lo(unsigned w) { return __uint_as_float(w << 16); }
__device__ __forceinline__ float bf_hi(unsigned w) { return __uint_as_float(w & 0xffff0000u); }
__device__ __forceinline__ float wave_sum(float v) {
#pragma unroll
    for (int o = 1; o < 64; o <<= 1) v += __shfl_xor(v, o);
    return v;
}
__device__ __forceinline__ float half_max(float m) { auto rr = __builtin_amdgcn_permlane32_swap(__float_as_uint(m), __float_as_uint(m), false, false); return fmaxf(__uint_as_float(rr[0]), __uint_as_float(rr[1])); }
__device__ __forceinline__ float half_sum(float m) { auto rr = __builtin_amdgcn_permlane32_swap(__float_as_uint(m), __float_as_uint(m), false, false); return __uint_as_float(rr[0]) + __uint_as_float(rr[1]); }
__device__ __forceinline__ int pi32(int i) { return (i & 0x13) | ((i & 8) >> 1) | ((i & 4) << 1); }
__device__ __forceinline__ float silu_f(float x) { return x * __builtin_amdgcn_rcpf(1.f + __expf(-x)); }
__device__ __forceinline__ int lane_now() { int l; asm volatile("v_mbcnt_lo_u32_b32 %0, -1, 0\n\tv_mbcnt_hi_u32_b32 %0, -1, %0" : "=v"(l)); return l; }
__device__ __forceinline__ void store_pair16(bf16* rowp16, u32x2 wk, u32x2 wk1) {
    auto r0 = __builtin_amdgcn_permlane32_swap(wk.x, wk1.x, false, false);
    auto r1 = __builtin_amdgcn_permlane32_swap(wk.y, wk1.y, false, false);
    u32x4 v; v.x = r0[0]; v.y = r1[0]; v.z = r0[1]; v.w = r1[1];
    *(u32x4*)rowp16 = v;
}
#define MFMA32(a, b, c) __builtin_amdgcn_mfma_f32_32x32x16_bf16((a), (b), (c), 0, 0, 0)

__device__ __forceinline__ void p0_silu_to_lds(const float* c, float* sc, int tid) {
#pragma unroll
    for (int i = 0; i < 8; ++i) { const float cb = c[tid + 512 * i]; sc[tid + 512 * i] = cb / (1.f + expf(-cb)); }
    __syncthreads();
}
__device__ __forceinline__ void p0_mod_item(const float* sc, const float* Wm, const float* bm, float* mod, int j0, float* red, int wid, int lane, int tid) {
    const int cl = lane & 31, kh = lane >> 5;
    float acc[4] = {0.f, 0.f, 0.f, 0.f};
#pragma unroll 16
    for (int i = 0; i < 64; ++i) {
        const int k = wid * 128 + 2 * i + kh; const float wv = Wm[(size_t)k * 3072 + j0 + cl];
#pragma unroll
        for (int b = 0; b < 4; ++b) acc[b] += sc[b * 1024 + k] * wv;
    }
#pragma unroll
    for (int b = 0; b < 4; ++b) acc[b] += __shfl_xor(acc[b], 32);
    if (lane < 32) {
#pragma unroll
        for (int b = 0; b < 4; ++b) red[(wid * 4 + b) * 32 + cl] = acc[b];
    }
    __syncthreads();
    if (tid < 128) { const int b = tid >> 5, c2 = tid & 31; float s = bm[j0 + c2];
#pragma unroll
        for (int w = 0; w < 8; ++w) s += red[(w * 4 + b) * 32 + c2];
        mod[b * 3072 + j0 + c2] = s; }
    __syncthreads();
}
__device__ __forceinline__ void p0_transpose_item(const float* W, int K, int N, bf16* WT, float* scr, int item, int lane, int nscale, float sc, int perm) {
    const int nblk = N / 32, kb = item / nblk, nb = item % nblk, k0 = 64 * kb, n0 = 32 * nb;
    int nd0 = n0;
    if (perm == 1) nd0 = (n0 < 2048 ? n0 : (n0 < 3072 ? n0 + 1024 : n0 - 1024));
    if (perm == 2) nd0 = (n0 < 1024 ? n0 : (n0 < 1536 ? n0 + 1792 : (n0 < 2688 ? n0 - 512 : n0 - 512)));
    const float f = (n0 < nscale) ? sc : 1.f;
#pragma unroll 8
    for (int i = 0; i < 32; ++i) { const int kk = 2 * i + (lane >> 5); scr[kk * 33 + (lane & 31)] = W[(size_t)(k0 + kk) * N + n0 + (lane & 31)] * f; }
    __builtin_amdgcn_wave_barrier();
    const int c = lane & 7;
#pragma unroll
    for (int j = 0; j < 4; ++j) { const int n = (lane >> 3) + 8 * j; const float* s = scr + (8 * c) * 33 + n;
        u32x4 o; o.x = cvtpk(s[0 * 33], s[1 * 33]); o.y = cvtpk(s[2 * 33], s[3 * 33]); o.z = cvtpk(s[4 * 33], s[5 * 33]); o.w = cvtpk(s[6 * 33], s[7 * 33]);
        *(u32x4*)(WT + (size_t)(nd0 + n) * K + k0 + 8 * c) = o; }
    __builtin_amdgcn_wave_barrier();
}

__device__ __forceinline__ void p_hrows(const float* X, bf16* H, const float* ng, const float* mod, int gw, int NGW, int lane) {
    for (int ch = gw; ch < M / 16; ch += NGW) {
        const int m0 = ch * 16, b = m0 / S; const float* mb = mod + b * 3072;
        f32x4 A[4], SH[4];
#pragma unroll
        for (int j = 0; j < 4; ++j) { const int col = 4 * lane + 256 * j; const f32x4 g = *(const f32x4*)(ng + col); const f32x4 sc = *(const f32x4*)(mb + 1024 + col); A[j] = g * (1.f + sc); SH[j] = *(const f32x4*)(mb + col); }
#pragma unroll 1
        for (int r0 = 0; r0 < 16; r0 += 4) {
            f32x4 v[4][4];
#pragma unroll
            for (int rr = 0; rr < 4; ++rr) { const float* xr = X + (size_t)(m0 + r0 + rr) * D;
#pragma unroll
                for (int j = 0; j < 4; ++j) v[rr][j] = *(const f32x4*)(xr + 4 * lane + 256 * j); }
#pragma unroll
            for (int rr = 0; rr < 4; ++rr) {
                float ss = 0.f;
#pragma unroll
                for (int j = 0; j < 4; ++j) ss += (v[rr][j].x * v[rr][j].x + v[rr][j].y * v[rr][j].y) + (v[rr][j].z * v[rr][j].z + v[rr][j].w * v[rr][j].w);
                ss = wave_sum(ss); const float rstd = 1.0f / sqrtf(ss * (1.f / D) + EPS);
                bf16* hr = H + (size_t)(m0 + r0 + rr) * D;
#pragma unroll
                for (int j = 0; j < 4; ++j) { const f32x4 o = v[rr][j] * rstd * A[j] + SH[j]; u32x2 w; w.x = cvtpk(o.x, o.y); w.y = cvtpk(o.z, o.w); *(u32x2*)(hr + 4 * lane + 256 * j) = w; }
            }
        }
    }
}

__device__ __forceinline__ void p_normrope(bf16* U, const int* pos, const float* aq, const float* ak, const float* bq, const float* bk, float* scr, int gw, int NGW, int lane) {
    const int sub = lane & 3, hsl = lane >> 2;
    const float invf = exp2f(-(float)(lane & 31) * (13.287712379549449f / 32.f));
    constexpr int NP = 1;
    int colp[NP]; float scp[NP]; bool validp[NP]; const float* gp[NP];
    { const int hs = hsl; validp[0] = hs < 10;
      if (hs < 8) { colp[0] = C_KA + 64 * hs; gp[0] = ak; scp[0] = 1.f; }
      else { colp[0] = C_KB + 64 * ((hs - 8) & 1); gp[0] = bk; scp[0] = 1.f; } }
    for (int ch = gw; ch < M / 16; ch += NGW) {
#pragma unroll 1
        for (int r0 = 0; r0 < 16; r0 += 4) {
            const int m0 = ch * 16 + r0;
            u32x4 xa[4][NP], xb[4][NP];
#pragma unroll
            for (int rr = 0; rr < 4; ++rr) { const bf16* ur = U + (size_t)(m0 + rr) * EU;
#pragma unroll
                for (int p = 0; p < NP; ++p) { xa[rr][p] = u32x4{0u, 0u, 0u, 0u}; xb[rr][p] = xa[rr][p];
                    if (validp[p]) { xa[rr][p] = *(const u32x4*)(ur + colp[p] + 8 * sub); xb[rr][p] = *(const u32x4*)(ur + colp[p] + 32 + 8 * sub); } } }
#pragma unroll
            for (int rr = 0; rr < 4; ++rr) {
                const float ang = (float)pos[m0 + rr] * invf;
                const float kq = rintf(ang * 0.15915494309189535f);
                float rd = fmaf(-kq, 6.28318548202514648f, ang); rd = fmaf(-kq, -1.74845553e-07f, rd);
                const float rv = rd * 0.15915494309189535f;
                scr[rr * 64 + lane] = (lane < 32) ? __builtin_amdgcn_cosf(rv) : __builtin_amdgcn_sinf(rv);
            }
            __builtin_amdgcn_wave_barrier();
#pragma unroll
            for (int rr = 0; rr < 4; ++rr) {
                float c8[8], s8[8];
#pragma unroll
                for (int i = 0; i < 8; ++i) { c8[i] = scr[rr * 64 + 8 * sub + i]; s8[i] = scr[rr * 64 + 32 + 8 * sub + i]; }
                bf16* ur = U + (size_t)(m0 + rr) * EU;
#pragma unroll
                for (int p = 0; p < NP; ++p) {
                    float x1[8], x2[8]; float ss = 0.f;
#pragma unroll
                    for (int i = 0; i < 4; ++i) { x1[2 * i] = bf_lo(xa[rr][p][i]); x1[2 * i + 1] = bf_hi(xa[rr][p][i]); x2[2 * i] = bf_lo(xb[rr][p][i]); x2[2 * i + 1] = bf_hi(xb[rr][p][i]); }
#pragma unroll
                    for (int i = 0; i < 8; ++i) ss += x1[i] * x1[i] + x2[i] * x2[i];
                    ss += __shfl_xor(ss, 1); ss += __shfl_xor(ss, 2);
                    const float rstd = 1.0f / sqrtf(ss * (1.f / 64.f) + EPS);
                    const float* g = gp[p]; const float sc = scp[p];
                    float o1[8], o2[8];
#pragma unroll
                    for (int i = 0; i < 8; ++i) { const float y1 = x1[i] * rstd * g[8 * sub + i], y2 = x2[i] * rstd * g[32 + 8 * sub + i];
                        o1[i] = (y1 * c8[i] - y2 * s8[i]) * sc; o2[i] = (y2 * c8[i] + y1 * s8[i]) * sc; }
                    if (validp[p]) { u32x4 wa, wb;
#pragma unroll
                        for (int i = 0; i < 4; ++i) { wa[i] = cvtpk(o1[2 * i], o1[2 * i + 1]); wb[i] = cvtpk(o2[2 * i], o2[2 * i + 1]); }
                        *(u32x4*)(ur + colp[p] + 8 * sub) = wa; *(u32x4*)(ur + colp[p] + 32 + 8 * sub) = wb; }
                }
            }
            __builtin_amdgcn_wave_barrier();
        }
    }
}

__device__ __forceinline__ void p_vt_item(const bf16* U, int ldu, int colbase, bf16* VT, int NC, int cdst0, int b, int s0, unsigned* scr, int lane) {
#pragma unroll
    for (int i = 0; i < 8; ++i) { const int row = i * 8 + (lane >> 3), ch = lane & 7;
        const u32x4 v = *(const u32x4*)(U + (size_t)(b * S + s0 + row) * ldu + colbase + 8 * ch);
        scr[row * 33 + 4 * ch + 0] = v.x; scr[row * 33 + 4 * ch + 1] = v.y; scr[row * 33 + 4 * ch + 2] = v.z; scr[row * 33 + 4 * ch + 3] = v.w; }
    __builtin_amdgcn_wave_barrier();
#pragma unroll
    for (int i = 0; i < 8; ++i) { const int c = i * 8 + (lane >> 3), ch = lane & 7; const int sh = (c & 1) * 16;
        unsigned hv[8];
#pragma unroll
        for (int k = 0; k < 8; ++k) hv[k] = (scr[(8 * ch + k) * 33 + (c >> 1)] >> sh) & 0xffffu;
        u32x4 o; o.x = hv[0] | (hv[1] << 16); o.y = hv[2] | (hv[3] << 16); o.z = hv[4] | (hv[5] << 16); o.w = hv[6] | (hv[7] << 16);
        *(u32x4*)(VT + (size_t)(b * NC + cdst0 + c) * S + s0 + 8 * ch) = o; }
    __builtin_amdgcn_wave_barrier();
}

constexpr int KROW = 144;
constexpr int KBUF_BYTES = 64 * KROW;
constexpr int VBUF128_BYTES = 128 * KROW;
constexpr int DK_BYTES = 8192, DV_BYTES = 16384;

__device__ __forceinline__ void qk_tile(f32x16& s0, f32x16& s1, const unsigned char* Kb, const bf16x8 (&qf)[4], int prow, int hi) {
    const unsigned char* k0 = Kb + prow * KROW + hi * 16;
    s0 = f32x16{}; s1 = f32x16{};
#pragma unroll
    for (int ks = 0; ks < 4; ++ks) {
        const bf16x8 a0 = *(const bf16x8*)(k0 + ks * 32), a1 = *(const bf16x8*)(k0 + 32 * KROW + ks * 32);
        s0 = MFMA32(a0, qf[ks], s0); s1 = MFMA32(a1, qf[ks], s1);
    }
}
__device__ __forceinline__ bf16x8 pack8(const f32x16& p, int base) {
    u32x4 w; w.x = cvtpk(p[base], p[base + 1]); w.y = cvtpk(p[base + 2], p[base + 3]); w.z = cvtpk(p[base + 4], p[base + 5]); w.w = cvtpk(p[base + 6], p[base + 7]);
    return __builtin_bit_cast(bf16x8, w);
}
template <int NDB>
__device__ __forceinline__ void sm_update(f32x16& s0, f32x16& s1, float& m, float& l, f32x16 (&o)[NDB], bf16x8 (&pk)[4]) {
    float mx = fmaxf(s0[0], s1[0]);
#pragma unroll
    for (int r = 1; r < 16; ++r) mx = fmaxf(mx, fmaxf(s0[r], s1[r]));
    mx = half_max(mx);
    const float mn = fmaxf(m, mx);
    if (__any(mn > m)) {
        const float f = (mn > m) ? __builtin_amdgcn_exp2f(m - mn) : 1.f;
        l *= f;
#pragma unroll
        for (int db = 0; db < NDB; ++db)
#pragma unroll
            for (int r = 0; r < 16; ++r) o[db][r] *= f;
        m = mn;
    }
    float ps = 0.f;
#pragma unroll
    for (int r = 0; r < 16; ++r) { s0[r] = __builtin_amdgcn_exp2f(s0[r] - m); s1[r] = __builtin_amdgcn_exp2f(s1[r] - m); ps += s0[r] + s1[r]; }
    l += ps;
    pk[0] = pack8(s0, 0); pk[1] = pack8(s0, 8); pk[2] = pack8(s1, 0); pk[3] = pack8(s1, 8);
}


__device__ __forceinline__ void q_norm_rope(bf16x8 (&qf)[4], const float* gain, int pos, int hi_) {
    const int hi = lane_now() >> 5; (void)hi_;
    float x[4][8]; float ss = 0.f;
#pragma unroll
    for (int ks = 0; ks < 4; ++ks) { const u32x4 w = __builtin_bit_cast(u32x4, qf[ks]);
#pragma unroll
        for (int i = 0; i < 4; ++i) { x[ks][2 * i] = bf_lo(w[i]); x[ks][2 * i + 1] = bf_hi(w[i]); } }
#pragma unroll
    for (int ks = 0; ks < 4; ++ks)
#pragma unroll
        for (int j = 0; j < 8; ++j) ss += x[ks][j] * x[ks][j];
    ss = half_sum(ss);
    const float rstd = 1.0f / sqrtf(ss * (1.f / 64.f) + EPS);
    const float fpos = (float)pos;
#pragma unroll
    for (int ks = 0; ks < 2; ++ks) {
        const f32x4 ga = *(const f32x4*)(gain + 16 * ks + 8 * hi), gb = *(const f32x4*)(gain + 16 * ks + 8 * hi + 4);
        const f32x4 gc = *(const f32x4*)(gain + 32 + 16 * ks + 8 * hi), gd = *(const f32x4*)(gain + 32 + 16 * ks + 8 * hi + 4);
#pragma unroll
        for (int j = 0; j < 8; ++j) {
            const int d = 16 * ks + 8 * hi + j;
            const float invf = exp2f(-(float)d * (13.287712379549449f / 32.f));
            const float ang = fpos * invf;
            const float kq = rintf(ang * 0.15915494309189535f);
            float rd = fmaf(-kq, 6.28318548202514648f, ang); rd = fmaf(-kq, -1.74845553e-07f, rd);
            const float rv = rd * 0.15915494309189535f;
            const float cs = __builtin_amdgcn_cosf(rv), sn = __builtin_amdgcn_sinf(rv);
            const float g1 = (j < 4) ? ga[j & 3] : gb[j & 3], g2 = (j < 4) ? gc[j & 3] : gd[j & 3];
            const float y1 = x[ks][j] * rstd * g1, y2 = x[ks + 2][j] * rstd * g2;
            x[ks][j] = (y1 * cs - y2 * sn) * QS; x[ks + 2][j] = (y2 * cs + y1 * sn) * QS;
        }
    }
#pragma unroll
    for (int ks = 0; ks < 4; ++ks) { u32x4 w;
#pragma unroll
        for (int i = 0; i < 4; ++i) w[i] = cvtpk(x[ks][2 * i], x[ks][2 * i + 1]);
        qf[ks] = __builtin_bit_cast(bf16x8, w); }
}

#define SBAR() __builtin_amdgcn_sched_barrier(0)
#define PIN(x) asm volatile("" : "+v"(x))
__device__ __forceinline__ float max3f(float a, float b, float c) { float r; asm("v_max3_f32 %0, %1, %2, %3" : "=v"(r) : "v"(a), "v"(b), "v"(c)); return r; }
template <bool FIXM> __device__ __forceinline__ void diff_unit(int b, int h, int qb, float lam, const bf16* U, const bf16* VTa, bf16* Y, const float* subg, const float* qgain, const int* pos, unsigned char* lds, int tid, int wid, int lane) {
    lane = lane_now(); tid = wid * 64 + lane;
    const int r32 = lane & 31, hi = lane >> 5, prow = pi32(r32);
    const int q0 = qb * 256, t0 = q0 + 32 * wid, tq = t0 + r32;
    const size_t rowbase = (size_t)b * S;
    const int NT = 4 * qb + 4, mylast = 4 * qb + (wid >> 1);
    f32x16 o[4];
#pragma unroll 1
    for (int c = 0; c < 2; ++c) {
        LAS unsigned char* qlds = (LAS unsigned char*)lds + 98304 + wid * 4096 + lane * 16;
        { const bf16* qp = U + (rowbase + tq) * EU + C_QA + (2 * h + c) * 64 + hi * 8; bf16x8 qraw[4];
#pragma unroll
          for (int ks = 0; ks < 4; ++ks) qraw[ks] = *(const bf16x8*)(qp + ks * 16);
          q_norm_rope(qraw, qgain, pos[rowbase + tq], hi);
#pragma unroll
          for (int ks = 0; ks < 4; ++ks) *(LAS bf16x8*)(qlds + ks * 1024) = qraw[ks]; }
#define QF(ks) (*(const LAS bf16x8*)(qlds + (ks) * 1024))
        const int srow = 8 * wid + (lane >> 3), sch = (lane & 7) ^ ((srow >> 1) & 7);
        const char* kb_u = (const char*)(U + rowbase * EU + C_KA + (2 * h + c) * 64);
        const char* vb_u = (const char*)(VTa + (size_t)(h * 128) * M + rowbase);
        const unsigned koff = (unsigned)(srow * EU + 8 * sch) * 2u, voff = (unsigned)(srow * M + 8 * sch) * 2u;
        LAS unsigned char* ldsl = (LAS unsigned char*)lds + wid * 1024;
#define DMA_K(t_, slot_) __builtin_amdgcn_global_load_lds((const unsigned*)(kb_u + (size_t)(t_) * (64 * EU * 2) + koff), (LAS unsigned*)(ldsl + (slot_) * DK_BYTES), 16, 0, 0)
#define DMA_V(t_, slot_) do { __builtin_amdgcn_global_load_lds((const unsigned*)(vb_u + (size_t)(t_) * 128 + voff), (LAS unsigned*)(ldsl + 4 * DK_BYTES + (slot_) * DV_BYTES), 16, 0, 0); \
                             __builtin_amdgcn_global_load_lds((const unsigned*)(vb_u + (size_t)(t_) * 128 + (size_t)64 * M * 2 + voff), (LAS unsigned*)(ldsl + 4 * DK_BYTES + (slot_) * DV_BYTES + 8192), 16, 0, 0); } while (0)
#define DMA_GROUP(t_) do { const int kt_ = ((t_) + 3 < NT) ? (t_) + 3 : NT - 1; int vt_ = ((t_) + 2 < NT) ? (t_) + 2 : NT - 1; vt_ = vt_ < 0 ? 0 : vt_; DMA_K(kt_, ((t_) + 3) & 3); DMA_V(vt_, ((t_) + 2) & 3); } while (0)
        DMA_GROUP(-3); DMA_GROUP(-2); DMA_GROUP(-1);
        asm volatile("s_waitcnt vmcnt(6)" ::: "memory");
        __builtin_amdgcn_s_barrier();
        float m = -INFINITY, l = 0.f;
#pragma unroll
        for (int db = 0; db < 4; ++db) o[db] = f32x16{};
        u32x4 pwA[4], pwB[4];
#pragma unroll
        for (int i = 0; i < 4; ++i) { pwA[i] = u32x4{0u, 0u, 0u, 0u}; pwB[i] = pwA[i]; }
        const LAS unsigned char* kfp = (const LAS unsigned char*)lds + prow * 128; const LAS unsigned char* vfp = (const LAS unsigned char*)lds + 4 * DK_BYTES + r32 * 128;
        unsigned kofs[4], vofs[4];
#pragma unroll
        for (int k4 = 0; k4 < 4; ++k4) { kofs[k4] = ((2 * k4 + hi) ^ ((prow >> 1) & 7)) * 16; vofs[k4] = ((2 * k4 + hi) ^ ((r32 >> 1) & 7)) * 16; }
#define KFRAG(Kb, i) (*(const LAS bf16x8*)((Kb) + ((i) & 1) * 4096 + kofs[(i) >> 1]))
#define VFRAG(Vb, j) (*(const LAS bf16x8*)((Vb) + ((j) & 3) * 4096 + vofs[(j) >> 2]))
#define DQK(T_) \
                f32x16 n0 = f32x16{}, n1 = f32x16{}; \
                { const LAS unsigned char* Kb = kfp + ((T_) & 3) * DK_BYTES; bf16x8 kf[2], qr[2]; \
                  _Pragma("unroll") for (int i = 0; i < 2; ++i) { kf[i] = KFRAG(Kb, i); qr[i] = QF(i); } \
                  SBAR(); \
                  _Pragma("unroll") for (int i = 0; i < 8; ++i) { \
                      if (i & 1) n1 = MFMA32(kf[i & 1], qr[(i >> 1) & 1], n1); else n0 = MFMA32(kf[i & 1], qr[(i >> 1) & 1], n0); \
                      if (i + 2 < 8) kf[i & 1] = KFRAG(Kb, i + 2); \
                      if ((i & 1) && (i >> 1) + 2 < 4) qr[(i >> 1) & 1] = QF((i >> 1) + 2); \
                      SBAR(); } } \
                if ((T_) == mylast) { \
                    int tqm = tq - 64 * (T_) - 8 * hi; asm volatile("" : "+v"(tqm)); \
                    _Pragma("unroll") for (int r = 0; r < 16; ++r) { const int key = 16 * (r >> 3) + (r & 7); if (key > tqm) n0[r] = -INFINITY; if (key + 32 > tqm) n1[r] = -INFINITY; } \
                } \
                bool resc = false; float mn = 0.f, f = 1.f; \
                if (!FIXM) { \
                    asm volatile("s_nop 15\n\ts_nop 7" : "+v"(n0), "+v"(n1));     \
                    float mx = max3f(n0[0], n1[0], n0[1]), mx2 = max3f(n1[1], n0[2], n1[2]); \
                    _Pragma("unroll") for (int r = 3; r < 15; r += 2) { mx = max3f(mx, n0[r], n1[r]); mx2 = max3f(mx2, n0[r + 1], n1[r + 1]); } \
                    mx = max3f(mx, n0[15], n1[15]); mx = fmaxf(mx, mx2); \
                    mx = half_max(mx); \
                    resc = __any(mx > m + 8.f); \
                    mn = resc ? fmaxf(m, mx) : m; \
                    f = (mn > m) ? __builtin_amdgcn_exp2f(m - mn) : 1.f; \
                    m = mn; } \
                float sacc = 0.f;
#define DEXP(j, PWN) { const float a0_ = ((j) < 8 ? n0[2 * ((j) & 7)] : n1[2 * ((j) & 7)]), a1_ = ((j) < 8 ? n0[2 * ((j) & 7) + 1] : n1[2 * ((j) & 7) + 1]); \
                      const float p0 = __builtin_amdgcn_exp2f(FIXM ? a0_ : a0_ - mn), p1 = __builtin_amdgcn_exp2f(FIXM ? a1_ : a1_ - mn); \
                      sacc += p0; sacc += p1; PWN[(j) >> 2][(j) & 3] = cvtpk(p0, p1); PIN(sacc); PIN(PWN[(j) >> 2]); }
#define DEND() asm volatile("s_waitcnt vmcnt(6) lgkmcnt(0)" ::: "memory"); __builtin_amdgcn_s_barrier();
#define DSTEP(T_, PWC, PWN) do { \
            DMA_GROUP(T_); \
            const LAS unsigned char* Vb = vfp + (((T_) - 1) & 3) * DV_BYTES; \
            if ((T_) <= mylast) { \
                DQK(T_) \
                bf16x8 vf[2]; \
                _Pragma("unroll") for (int j = 0; j < 2; ++j) vf[j] = VFRAG(Vb, j); \
                SBAR(); \
                _Pragma("unroll") for (int j = 0; j < 16; ++j) { \
                    o[j & 3] = MFMA32(vf[j & 1], __builtin_bit_cast(bf16x8, PWC[j >> 2]), o[j & 3]); \
                    if (j + 2 < 16) vf[j & 1] = VFRAG(Vb, j + 2); \
                    DEXP(j, PWN) \
                    SBAR(); } \
                if (resc) { l *= f; \
                    _Pragma("unroll") for (int db = 0; db < 4; ++db) _Pragma("unroll") for (int r = 0; r < 16; ++r) o[db][r] *= f; } \
                l += sacc; \
            } else if ((T_) - 1 <= mylast) { \
                _Pragma("unroll") for (int j = 0; j < 16; ++j) { const bf16x8 vf = VFRAG(Vb, j); o[j & 3] = MFMA32(vf, __builtin_bit_cast(bf16x8, PWC[j >> 2]), o[j & 3]); if ((j & 3) == 3) SBAR(); } \
            } \
            DEND() \
        } while (0)
        {
            DMA_GROUP(0);
            DQK(0)
#pragma unroll
            for (int j = 0; j < 16; ++j) DEXP(j, pwA)
            (void)resc; (void)f;
            l = sacc;
            DEND()
        }
#pragma unroll 1
        for (int t2 = 1; t2 <= NT; t2 += 2) {
            DSTEP(t2, pwA, pwB);
            if (t2 + 1 <= NT) DSTEP(t2 + 1, pwB, pwA);
        }
#undef DSTEP
#undef DQK
#undef DEXP
#undef DEND
        asm volatile("s_waitcnt vmcnt(0)" ::: "memory");
        __builtin_amdgcn_s_barrier();
#undef KFRAG
#undef VFRAG
#undef QF
#undef DMA_K
#undef DMA_V
#undef DMA_GROUP
        const float inv = 1.0f / half_sum(l);
        bf16* yst = Y + (rowbase + tq) * D + h * 128 + 4 * hi;
        if (c == 0) {
#pragma unroll
            for (int db = 0; db < 4; ++db)
#pragma unroll
                for (int g4 = 0; g4 < 4; ++g4) { u32x2 w; w.x = cvtpk(o[db][4 * g4] * inv, o[db][4 * g4 + 1] * inv); w.y = cvtpk(o[db][4 * g4 + 2] * inv, o[db][4 * g4 + 3] * inv); *(u32x2*)(yst + 32 * db + 8 * g4) = w; }
        } else {
            const float li = lam * inv;
#pragma unroll
            for (int db = 0; db < 4; ++db)
#pragma unroll
                for (int g4 = 0; g4 < 4; ++g4) { const u32x2 w = *(const u32x2*)(yst + 32 * db + 8 * g4);
                    o[db][4 * g4] = bf_lo(w.x) - o[db][4 * g4] * li; o[db][4 * g4 + 1] = bf_hi(w.x) - o[db][4 * g4 + 1] * li;
                    o[db][4 * g4 + 2] = bf_lo(w.y) - o[db][4 * g4 + 2] * li; o[db][4 * g4 + 3] = bf_hi(w.y) - o[db][4 * g4 + 3] * li; }
        }
    }
    float ss = 0.f;
#pragma unroll
    for (int db = 0; db < 4; ++db)
#pragma unroll
        for (int r = 0; r < 16; ++r) ss += o[db][r] * o[db][r];
    ss = half_sum(ss);
    const float rstd = 0.8f / sqrtf(ss * (1.f / 128.f) + EPS);
    const int lane_e = lane_now();
    const int hi_e = lane_e >> 5, tq_e = t0 + (lane_e & 31);
    const bf16* gar = U + (rowbase + tq_e) * EU + C_GA + h * 128;
    bf16* yr = Y + (rowbase + tq_e) * D + h * 128; u32x2 wprev = {0u, 0u};
#pragma unroll
    for (int db = 0; db < 4; ++db)
#pragma unroll
        for (int g4 = 0; g4 < 4; ++g4) {
            const int e = 32 * db + 8 * g4 + 4 * hi_e;
            const u32x2 gw = *(const u32x2*)(gar + e); const f32x4 sg = *(const f32x4*)(subg + e);
            const float y0 = o[db][4 * g4 + 0] * rstd * sg.x * silu_f(bf_lo(gw.x)), y1 = o[db][4 * g4 + 1] * rstd * sg.y * silu_f(bf_hi(gw.x));
            const float y2 = o[db][4 * g4 + 2] * rstd * sg.z * silu_f(bf_lo(gw.y)), y3 = o[db][4 * g4 + 3] * rstd * sg.w * silu_f(bf_hi(gw.y));
            u32x2 w; w.x = cvtpk(y0, y1); w.y = cvtpk(y2, y3);
            if ((g4 & 1) == 0) wprev = w; else store_pair16(yr + 32 * db + 16 * (g4 >> 1) + 8 * hi_e, wprev, w);
        }
}

__device__ __forceinline__ void swa_unit(int b, int kvh, int qb, const bf16* U, const bf16* VTb, bf16* Y, const float* sinks, const float* qgain, const int* pos, unsigned char* lds, int wid, int lane) {
    const int r32 = lane & 31, hi = lane >> 5, prow = pi32(r32);
    const int q0 = qb * 256, t0 = q0 + 32 * wid, tq = t0 + r32;
    const size_t rowbase = (size_t)b * S;
    const int T0 = (q0 >= 128) ? (q0 - 128) >> 6 : 0, T1 = (q0 + 255) >> 6, nT = T1 - T0 + 1;
    {
        const int srow = 8 * wid + (lane >> 3), sch = (lane & 7) ^ ((srow >> 1) & 7);
        const char* kb_u = (const char*)(U + (rowbase + 64 * T0) * EU + C_KB + kvh * 64);
        const char* vb_u = (const char*)(VTb + ((size_t)(b * 128 + kvh * 64)) * S + 64 * T0);
        const unsigned koff = (unsigned)(srow * EU + 8 * sch) * 2u, voff = (unsigned)(srow * S + 8 * sch) * 2u;
        LAS unsigned char* ldsl = (LAS unsigned char*)lds + wid * 1024;
#pragma unroll 1
        for (int s = 0; s < nT; ++s) {
            __builtin_amdgcn_global_load_lds((const unsigned*)(kb_u + (size_t)s * (64 * EU * 2) + koff), (LAS unsigned*)(ldsl + s * 8192), 16, 0, 0);
            __builtin_amdgcn_global_load_lds((const unsigned*)(vb_u + (size_t)s * 128 + voff), (LAS unsigned*)(ldsl + 49152 + s * 8192), 16, 0, 0);
        }
        asm volatile("s_waitcnt vmcnt(0)" ::: "memory");
        __syncthreads();
    }
    const LAS unsigned char* kfp = (const LAS unsigned char*)lds + prow * 128; const LAS unsigned char* vfp = (const LAS unsigned char*)lds + 49152 + r32 * 128;
    unsigned kofs[4], vofs[4];
#pragma unroll
    for (int k4 = 0; k4 < 4; ++k4) { kofs[k4] = ((2 * k4 + hi) ^ ((prow >> 1) & 7)) * 16; vofs[k4] = ((2 * k4 + hi) ^ ((r32 >> 1) & 7)) * 16; }
    const int tlo = (t0 >= 127) ? (t0 - 127) >> 6 : 0, thi = (t0 + 31) >> 6;
#pragma unroll 1
    for (int g = 0; g < 4; ++g) {
        const int qh = kvh * 4 + g;
        bf16x8 qf[4];
        { const bf16* qp = U + (rowbase + tq) * EU + C_QB + qh * 64 + hi * 8;
#pragma unroll
          for (int ks = 0; ks < 4; ++ks) qf[ks] = *(const bf16x8*)(qp + ks * 16); }
        q_norm_rope(qf, qgain, pos[rowbase + tq], hi);
        float m = sinks[qh] * LOG2E, l = (hi == 0) ? 1.f : 0.f;
        f32x16 o[2]; o[0] = f32x16{}; o[1] = f32x16{};
#pragma unroll 1
        for (int t = tlo; t <= thi; ++t) {
            const LAS unsigned char* Kb = kfp + (t - T0) * 8192; const LAS unsigned char* Vb = vfp + (t - T0) * 8192;
            f32x16 s0 = f32x16{}, s1 = f32x16{};
#pragma unroll
            for (int ks = 0; ks < 4; ++ks) { const bf16x8 a0 = *(const LAS bf16x8*)(Kb + kofs[ks]), a1 = *(const LAS bf16x8*)(Kb + 4096 + kofs[ks]); s0 = MFMA32(a0, qf[ks], s0); s1 = MFMA32(a1, qf[ks], s1); }
            const int rel = tq - 64 * t - 8 * hi;
#pragma unroll
            for (int r = 0; r < 16; ++r) { const int key = 16 * (r >> 3) + (r & 7);
                if (key > rel || rel - key >= 128) s0[r] = -INFINITY;
                if (key + 32 > rel || rel - (key + 32) >= 128) s1[r] = -INFINITY; }
            bf16x8 pk[4]; sm_update<2>(s0, s1, m, l, o, pk);
#pragma unroll
            for (int db = 0; db < 2; ++db)
#pragma unroll
                for (int kk = 0; kk < 4; ++kk) { const bf16x8 vf = *(const LAS bf16x8*)(Vb + db * 4096 + vofs[kk]); o[db] = MFMA32(vf, pk[kk], o[db]); }
        }
        const float inv = 1.0f / half_sum(l);
        const bf16* gbr = U + (rowbase + tq) * EU + C_GB + qh * 64;
        bf16* yr = Y + (rowbase + tq) * D + 512 + qh * 64; u32x2 wprev = {0u, 0u};
#pragma unroll
        for (int db = 0; db < 2; ++db)
#pragma unroll
            for (int g4 = 0; g4 < 4; ++g4) {
                const int e = 32 * db + 8 * g4 + 4 * hi;
                const u32x2 gw = *(const u32x2*)(gbr + e);
                const float y0 = o[db][4 * g4 + 0] * inv * silu_f(bf_lo(gw.x)), y1 = o[db][4 * g4 + 1] * inv * silu_f(bf_hi(gw.x));
                const float y2 = o[db][4 * g4 + 2] * inv * silu_f(bf_lo(gw.y)), y3 = o[db][4 * g4 + 3] * inv * silu_f(bf_hi(gw.y));
                u32x2 w; w.x = cvtpk(y0, y1); w.y = cvtpk(y2, y3);
                if ((g4 & 1) == 0) wprev = w; else store_pair16(yr + 32 * db + 16 * (g4 >> 1) + 8 * hi, wprev, w);
            }
    }
    __syncthreads();
}

__device__ __forceinline__ void sb_unit(int b, int h, int qb, const bf16* U, const bf16* VT, bf16* Y, unsigned char* lds, int wid, int lane, int& res_lo, int& res_hi) {
    lane = lane_now();
    const int r32 = lane & 31, hi = lane >> 5, prow = pi32(r32);
    const int q0 = qb * 256, t0 = q0 + 32 * wid, tq = t0 + r32;
    const size_t rowbase = (size_t)b * S;
    const int mytile = 4 * qb + (wid >> 1);
    bf16x8 TM[2], JN;
#pragma unroll
    for (int s2 = 0; s2 < 2; ++s2)
#pragma unroll
        for (int j = 0; j < 8; ++j) TM[s2][j] = (16 * s2 + 8 * hi + j > prow) ? (short)0xBF80 : (short)0;
#pragma unroll
    for (int j = 0; j < 8; ++j) JN[j] = (short)0xBF80;
    bf16x8 qf[4];
    { const bf16* qp = U + (rowbase + tq) * U1LD + h * 64 + hi * 8;
#pragma unroll
      for (int ks = 0; ks < 4; ++ks) qf[ks] = *(const bf16x8*)(qp + ks * 16); }
    u32x2 gwv[2][4];
    { const bf16* gr0 = U + (rowbase + tq) * U1LD + 2048 + h * 64 + 4 * hi;
#pragma unroll
      for (int db = 0; db < 2; ++db)
#pragma unroll
          for (int g4 = 0; g4 < 4; ++g4) gwv[db][g4] = *(const u32x2*)(gr0 + 32 * db + 8 * g4); }
    const int srow = 8 * wid + (lane >> 3), sch = (lane & 7) ^ ((srow >> 1) & 7);
    const char* kb_u = (const char*)(U + rowbase * U1LD + 1024 + h * 64);
    const char* vb_u = (const char*)(VT + (size_t)(h * 64) * M + rowbase);
    const unsigned koff = (unsigned)(srow * U1LD + 8 * sch) * 2u, voff = (unsigned)(srow * M + 8 * sch) * 2u;
    LAS unsigned char* ldsl = (LAS unsigned char*)lds + wid * 1024;
    const LAS unsigned char* kfp = (const LAS unsigned char*)lds + prow * 128; const LAS unsigned char* vfp = (const LAS unsigned char*)lds + 8192 + r32 * 128;
    unsigned kofs[4], vofs[4];
#pragma unroll
    for (int k4 = 0; k4 < 4; ++k4) { kofs[k4] = ((2 * k4 + hi) ^ ((prow >> 1) & 7)) * 16; vofs[k4] = ((2 * k4 + hi) ^ ((r32 >> 1) & 7)) * 16; }
    f32x16 C = f32x16{}; f32x16 o[2]; o[0] = f32x16{}; o[1] = f32x16{};
    bool alive = true;
    volatile unsigned* flg = (volatile unsigned*)(lds + LDS_MISC + 128);
#pragma unroll 1
    for (int top = 4 * qb + 3; ; top -= 7) {
        const int lo = (top >= 6) ? top - 6 : 0;
#pragma unroll 1
        for (int t = top; t >= lo; --t) {
            if (t >= res_lo && t <= res_hi) continue;
            __builtin_amdgcn_global_load_lds((const unsigned*)(kb_u + (size_t)t * (64 * U1LD * 2) + koff), (LAS unsigned*)(ldsl + (t & 7) * 16384), 16, 0, 0);
            __builtin_amdgcn_global_load_lds((const unsigned*)(vb_u + (size_t)t * 128 + voff), (LAS unsigned*)(ldsl + (t & 7) * 16384 + 8192), 16, 0, 0);
        }
        { const int nh = (res_hi < lo + 7) ? res_hi : lo + 7; res_hi = (nh > top) ? nh : top; res_lo = lo; if (res_hi > lo + 7) res_hi = lo + 7; }
        asm volatile("s_waitcnt vmcnt(0)" ::: "memory");
        __syncthreads();
#pragma unroll 1
        for (int t = (top < mytile ? top : mytile); t >= lo && alive; --t) {
            const LAS unsigned char* Kb = kfp + (t & 7) * 16384; const LAS unsigned char* Vb = vfp + (t & 7) * 16384;
            f32x16 y0 = f32x16{}, y1 = f32x16{};
#pragma unroll
            for (int ks = 0; ks < 4; ++ks) { const bf16x8 a0 = *(const LAS bf16x8*)(Kb + kofs[ks]), a1 = *(const LAS bf16x8*)(Kb + 4096 + kofs[ks]); y0 = MFMA32(a0, qf[ks], y0); y1 = MFMA32(a1, qf[ks], y1); }
#pragma unroll
            for (int r = 0; r < 16; ++r) { y0[r] = fminf(y0[r], 100.f); y1[r] = fminf(y1[r], 100.f); }
            if (t == mytile) {
                int tqm = tq - 64 * t - 8 * hi; asm volatile("" : "+v"(tqm));
#pragma unroll
                for (int r = 0; r < 16; ++r) { const int key = 16 * (r >> 3) + (r & 7); if (key >= tqm) y0[r] = -INFINITY; if (key + 32 >= tqm) y1[r] = -INFINITY; }
            }
            f32x16 l0, l1;
#pragma unroll
            for (int r = 0; r < 16; ++r) { l0[r] = __builtin_amdgcn_logf(1.f + __builtin_amdgcn_exp2f(y0[r])); l1[r] = __builtin_amdgcn_logf(1.f + __builtin_amdgcn_exp2f(y1[r])); }
            bf16x8 lb[4]; lb[0] = pack8(l0, 0); lb[1] = pack8(l0, 8); lb[2] = pack8(l1, 0); lb[3] = pack8(l1, 8);
#pragma unroll
            for (int r = 0; r < 16; ++r) { y0[r] -= l0[r]; y1[r] -= l1[r]; }
            f32x16 X = MFMA32(JN, lb[2], C); X = MFMA32(JN, lb[3], X);
            f32x16 f1 = MFMA32(TM[0], lb[2], C); f1 = MFMA32(TM[1], lb[3], f1);
            f32x16 f0 = MFMA32(TM[0], lb[0], X); f0 = MFMA32(TM[1], lb[1], f0);
            C = MFMA32(JN, lb[0], X); C = MFMA32(JN, lb[1], C);
#pragma unroll
            for (int r = 0; r < 16; ++r) { y0[r] = __builtin_amdgcn_exp2f(y0[r] + f0[r]); y1[r] = __builtin_amdgcn_exp2f(y1[r] + f1[r]); }
            bf16x8 pk[4]; pk[0] = pack8(y0, 0); pk[1] = pack8(y0, 8); pk[2] = pack8(y1, 0); pk[3] = pack8(y1, 8);
#pragma unroll
            for (int db = 0; db < 2; ++db)
#pragma unroll
                for (int kk = 0; kk < 4; ++kk) { const bf16x8 vf = *(const LAS bf16x8*)(Vb + db * 4096 + vofs[kk]); o[db] = MFMA32(vf, pk[kk], o[db]); }
            alive = __any(C[0] > -160.f);
        }
        if (lo == 0) break;
        if (lane == 0) flg[wid] = alive ? 1u : 0u;
        __syncthreads();
        const bool any_alive = __any(flg[lane & 7] != 0u);
        if (!any_alive) break;
        __syncthreads();
    }
    __syncthreads();
    const int lane_e = lane_now(); const int hi_e = lane_e >> 5, tq_e = t0 + (lane_e & 31);
    bf16* yr = Y + (rowbase + tq_e) * D + h * 64; u32x2 wprev = {0u, 0u};
#pragma unroll
    for (int db = 0; db < 2; ++db)
#pragma unroll
        for (int g4 = 0; g4 < 4; ++g4) {
            const int e = 32 * db + 8 * g4 + 4 * hi_e;
            const u32x2 gw = gwv[db][g4];
            const float y0 = o[db][4 * g4 + 0] * silu_f(bf_lo(gw.x)), y1 = o[db][4 * g4 + 1] * silu_f(bf_hi(gw.x));
            const float y2 = o[db][4 * g4 + 2] * silu_f(bf_lo(gw.y)), y3 = o[db][4 * g4 + 3] * silu_f(bf_hi(gw.y));
            u32x2 w; w.x = cvtpk(y0, y1); w.y = cvtpk(y2, y3);
            if ((g4 & 1) == 0) wprev = w; else store_pair16(yr + 32 * db + 16 * (g4 >> 1) + 8 * hi_e, wprev, w);
        }
}

#define XB_TMO      128
#define XB_XCNT(j)  (256  + 64 * (j))
#define XB_XSUB(j)  (1280 + 64 * (j))
#define XB_XGEN(j)  (2304 + 64 * (j))
#define XB_TOP      3328
#define XB_TOPGEN   3392
#define XCD_BAR_WORDS 3456
#define XB_SPIN_CAP (1u << 18)

__device__ __forceinline__ unsigned xb_ld(unsigned* p)              { return __hip_atomic_load(p, __ATOMIC_RELAXED, __HIP_MEMORY_SCOPE_AGENT); }
__device__ __forceinline__ unsigned xb_add(unsigned* p, unsigned v) { return __hip_atomic_fetch_add(p, v, __ATOMIC_RELAXED, __HIP_MEMORY_SCOPE_AGENT); }
__device__ __forceinline__ unsigned xb_xcc_id() { return (unsigned)__builtin_amdgcn_s_getreg((3 << 11) | 20) & 0xFu; }
#define XB_SPIN(cond, bar) do { unsigned _sp = 0; while (cond) { __builtin_amdgcn_s_sleep(1); \
    if ((++_sp & 255u) == 0u) { if (xb_ld(&(bar)[XB_TMO])) break; if (_sp > XB_SPIN_CAP) { atomicAdd(&(bar)[XB_TMO], 1u); break; } } } } while (0)

struct XcdBarrier {
    unsigned* bar; unsigned x;
    volatile LAS unsigned* st;
};

__device__ __forceinline__ XcdBarrier xcd_barrier_post(unsigned* bar, volatile LAS unsigned* st, bool t0) {
    XcdBarrier b; b.bar = bar; b.x = xb_xcc_id(); b.st = st;
    if (t0) (void)xb_add(&bar[XB_XCNT(b.x)], 1u);
    return b;
}
__device__ __forceinline__ void xcd_barrier_complete(unsigned* bar, unsigned x, unsigned& nloc, unsigned& nx) {
    const unsigned G = gridDim.x * gridDim.y * gridDim.z;
    unsigned sum, cnt, mine, sp = 0u;
    for (;;) {
        sum = 0u; cnt = 0u; mine = 0u;
#pragma unroll
        for (unsigned j = 0; j < 16; ++j) { const unsigned c = xb_ld(&bar[XB_XCNT(j)]); sum += c; cnt += (c > 0u) ? 1u : 0u; mine = (j == x) ? c : mine; }
        if (sum == G) break;
        __builtin_amdgcn_s_sleep(1);
        if ((++sp & 255u) == 0u) { if (xb_ld(&bar[XB_TMO])) break; if (sp > XB_SPIN_CAP) { atomicAdd(&bar[XB_TMO], 1u); break; } }
    }
    nloc = mine > 0u ? mine : 1u; nx = cnt > 0u ? cnt : 1u;
}

__device__ __forceinline__ void xcd_barrier(const XcdBarrier& b, bool t0) {
    asm volatile("s_waitcnt vmcnt(0)" ::: "memory");
    __syncthreads();
    if (t0) {
        unsigned* bar = b.bar;
        __builtin_amdgcn_s_waitcnt(0);
        unsigned nloc = b.st[0], nx = b.st[1];
        if (nloc == 0u) { xcd_barrier_complete(bar, b.x, nloc, nx); b.st[0] = nloc; b.st[1] = nx; }
        const unsigned old = xb_add(&bar[XB_XSUB(b.x)], 1u);
        const unsigned gen = old / nloc;
        if (old + 1u == (gen + 1u) * nloc) {
            __builtin_amdgcn_fence(__ATOMIC_RELEASE, "agent");
            asm volatile("s_waitcnt vmcnt(0)" ::: "memory");
            const unsigned og = xb_add(&bar[XB_TOP], 1u);
            const unsigned tg = og / nx;
            if (og + 1u == (tg + 1u) * nx) xb_add(&bar[XB_TOPGEN], 1u);
            else XB_SPIN(xb_ld(&bar[XB_TOPGEN]) == tg, bar);
            __builtin_amdgcn_fence(__ATOMIC_ACQUIRE, "agent");
            xb_add(&bar[XB_XGEN(b.x)], 1u);
            asm volatile("s_waitcnt vmcnt(0)" ::: "memory");
        } else {
            XB_SPIN(xb_ld(&bar[XB_XGEN(b.x)]) == gen, bar);
            __builtin_amdgcn_fence(__ATOMIC_ACQUIRE, "agent");
            asm volatile("s_waitcnt vmcnt(0)" ::: "memory");
        }
    }
    __syncthreads();
}

#ifndef MK_SINGLE
#define MK_SINGLE 1
#endif
constexpr int NPHASE = 11;
struct Args { const float* in[23]; float* out; unsigned char* ws; int ph_lo, ph_hi; };

__global__ void __launch_bounds__(NWAVES * 64, 2) hybrid_fwd(Args args) {
    extern __shared__ __attribute__((aligned(16))) unsigned char lds[];
    const int wid = __builtin_amdgcn_readfirstlane((int)threadIdx.x >> 6);
    const int G = gridDim.x; const int bx = blockIdx.x;
    const int vcu = (G % 8 == 0) ? (bx % 8) * (G / 8) + bx / 8 : bx;
    const int gw = vcu * NWAVES + wid, NGW = G * NWAVES;
#define LANE_TID() const int lane = lane_now(); const int tid = wid * 64 + lane; (void)tid
    unsigned char* ws = args.ws;
    const float* x = args.in[0]; const float* cvec = args.in[1]; const int* pos = (const int*)args.in[2];
    float* mod_e = (float*)(ws + WS_MOD); float* mod_o = mod_e + 4 * 3072;
    bf16* WinE = (bf16*)(ws + WS_WINE); bf16* WoutE = (bf16*)(ws + WS_WOUTE); bf16* WinO = (bf16*)(ws + WS_WINO); bf16* WoutO = (bf16*)(ws + WS_WOUTO);
    bf16* H = (bf16*)(ws + WS_H); bf16* Y = H; bf16* VT = (bf16*)(ws + WS_VT); bf16* U = (bf16*)(ws + WS_U);
    bf16* VTa = VT; bf16* VTb = VT + (size_t)512 * M;
    float* scrf = (float*)(lds + LDS_SCR + wid * 8448);
    const int lo = args.ph_lo, hi_ph = args.ph_hi;
#define IN(k) (lo <= (k) && (k) < hi_ph)
#define SEAM(k) do { if (IN(k) && IN((k) + 1)) { xcd_barrier(bar, wid == 0 && lane_now() == 0); } } while (0)
    if (args.ph_lo < 0) cg::this_grid().sync();
    volatile LAS unsigned* MISC = (volatile LAS unsigned*)((LAS unsigned char*)lds + LDS_MISC);
    if (wid == 0) MISC[lane_now()] = 0u;
    __syncthreads();
    XcdBarrier bar = xcd_barrier_post((unsigned*)(ws + WS_BAR), MISC + 8, wid == 0 && lane_now() == 0);

    if (IN(0)) {
        LANE_TID();
        if (bx < 192) p0_silu_to_lds(cvec, (float*)lds + 1024, tid);
        for (int it = bx; it < 192; it += G) {
            const int l = it / 96, j0 = (it % 96) * 32;
            p0_mod_item((const float*)lds + 1024, l ? args.in[19] : args.in[4], (l ? args.in[20] : args.in[5]), l ? mod_o : mod_e, j0, (float*)lds, wid, lane, tid);
        }
        constexpr int I_INE = 16 * (EIN / 32), I_OUT = 16 * (D / 32), I_INO = 16 * (OIN / 32);
        constexpr int NITEMS = I_INE + I_OUT + I_INO + I_OUT;
        for (int it = gw; it < NITEMS; it += NGW) {
            int r = it;
            if (r < I_INE) { p0_transpose_item(args.in[6], D, EIN, WinE, scrf, r, lane, 0, 1.f, 2); continue; } r -= I_INE;
            if (r < I_OUT) { p0_transpose_item(args.in[17], D, D, WoutE, scrf, r, lane, 0, 1.f, 0); continue; } r -= I_OUT;
            if (r < I_INO) { p0_transpose_item(args.in[21], D, OIN, WinO, scrf, r, lane, 1024, QS, 1); continue; } r -= I_INO;
            p0_transpose_item(args.in[22], D, D, WoutO, scrf, r, lane, 0, 1.f, 0);
        }
    }
    SEAM(0);
    if (IN(1)) { LANE_TID(); p_hrows(x, H, args.in[3], mod_e, gw, NGW, lane); }
    SEAM(1);
    if (IN(2)) {
        { pg8::Gemm g{H, WinE, M, EU, D}; pg8::StaticOrder So; So.init(M, EU, G, bx);
          pg8::EpiStore E{U, EU};
          pg8::gemm_phase<pg8::EpiStore, pg8::StaticOrder, true, true>((PG8_LAS unsigned char*)lds, g, So, E, wid); }
        { pg8::Gemm g{WinE + (size_t)EU * D, H, 512, M, D}; pg8::StaticOrder So; So.init(512, M, G, bx);
          pg8::EpiStore E{VTa, M};
          pg8::gemm_phase<pg8::EpiStore, pg8::StaticOrder, true, true>((PG8_LAS unsigned char*)lds, g, So, E, wid); }
    }
    SEAM(2);
    if (IN(3)) {
        LANE_TID();
        p_normrope(U, pos, args.in[7], args.in[8], args.in[14], args.in[15], scrf, gw, NGW, lane);
        for (int it = gw; it < 4 * 128 * 2; it += NGW) {
            const int ct = it & 1, st = (it >> 1) & 127, b = it >> 8;
            p_vt_item(U, EU, C_VB + 64 * ct, VTb, 128, 64 * ct, b, 64 * st, (unsigned*)scrf, lane);
        }
    }
    SEAM(3);
    if (IN(4)) {
        const int lane4 = lane_now(); const int tid4 = wid * 64 + lane4;
        float lam;
        { const float p1 = args.in[9][lane4] * args.in[10][lane4], p2 = args.in[11][lane4] * args.in[12][lane4];
          lam = expf(wave_sum(p1)) - expf(wave_sum(p2)) + 0.2f; }
        bool fixm;
        { float gq = fabsf(args.in[7][lane4]), gk = fabsf(args.in[8][lane4]);
#pragma unroll
          for (int o2 = 1; o2 < 64; o2 <<= 1) { gq = fmaxf(gq, __shfl_xor(gq, o2)); gk = fmaxf(gk, __shfl_xor(gk, o2)); }
          fixm = (8.f * gq * gk * LOG2E <= 100.f); }
#ifndef NO_DIFF
        for (int p = vcu; p < 256; p += G) {
            const int bh = p >> 4, s = p & 15;
#pragma unroll 1
            for (int hf = 0; hf < 2; ++hf) {
                if (fixm) diff_unit<true>(bh >> 2, bh & 3, hf ? 31 - s : s, lam, U, VTa, Y, args.in[13], args.in[7], pos, lds, tid4, wid, lane4);
                else diff_unit<false>(bh >> 2, bh & 3, hf ? 31 - s : s, lam, U, VTa, Y, args.in[13], args.in[7], pos, lds, tid4, wid, lane4);
            }
        }
#endif
        const int lane4b = lane_now();
#ifndef NO_SWA
        for (int u = vcu; u < 256; u += G) swa_unit(u >> 6, (u >> 5) & 1, u & 31, U, VTb, Y, args.in[16], args.in[14], pos, lds, wid, lane4b);
#endif
    }
    SEAM(4);
    if (IN(5)) {
        pg8::Gemm g{Y, WoutE, M, D, D}; pg8::StaticOrder So; So.init(M, D, G, bx);
        pg8::EpiResid E{x, args.out, mod_e + 2048};
        pg8::gemm_phase<pg8::EpiResid, pg8::StaticOrder, true, true>((PG8_LAS unsigned char*)lds, g, So, E, wid);
    }
    SEAM(5);
    if (IN(6)) { LANE_TID(); p_hrows(args.out, H, args.in[18], mod_o, gw, NGW, lane); }
    SEAM(6);
    if (IN(7)) {
        { pg8::Gemm g{H, WinO, M, U1LD, D}; pg8::StaticOrder So; So.init(M, U1LD, G, bx);
          pg8::EpiStore E{U, U1LD};
          pg8::gemm_phase<pg8::EpiStore, pg8::StaticOrder, true, true>((PG8_LAS unsigned char*)lds, g, So, E, wid); }
        { pg8::Gemm g{WinO + (size_t)U1LD * D, H, 1024, M, D}; pg8::StaticOrder So; So.init(1024, M, G, bx);
          pg8::EpiStore E{VT, M};
          pg8::gemm_phase<pg8::EpiStore, pg8::StaticOrder, true, true>((PG8_LAS unsigned char*)lds, g, So, E, wid); }
    }
    SEAM(7);
    if (IN(9)) {
        const int lane9 = lane_now(); const int tid9 = wid * 64 + lane9;
        for (int run = vcu; run < 256; run += G) {
            const int bh = run >> 2; int res_lo = 1 << 30, res_hi = -1;
#pragma unroll 1
            for (int i = 7; i >= 0; --i) sb_unit(bh >> 4, bh & 15, (run & 3) * 8 + i, U, VT, Y, lds, wid, lane9, res_lo, res_hi);
        }
    }
    SEAM(9);
    if (IN(10)) {
        pg8::Gemm g{Y, WoutO, M, D, D}; pg8::StaticOrder So; So.init(M, D, G, bx);
        pg8::EpiResid E{args.out, args.out, mod_o + 2048};
        pg8::gemm_phase<pg8::EpiResid, pg8::StaticOrder, true, true>((PG8_LAS unsigned char*)lds, g, So, E, wid);
    }
#undef IN
#undef SEAM
}

extern "C" void kernel_launch(void* const* d_in, const int* in_sizes, int n_in, void* d_out, int out_size, void* d_ws, size_t ws_size, hipStream_t stream) {
    static int grid = 0;
    if (grid == 0) {
        if (n_in != 23 || out_size != M * D || ws_size < WS_END) { fprintf(stderr, "kernel_launch: unexpected shapes (n_in %d out %d ws %zu)\n", n_in, out_size, ws_size); grid = -1; return; }
        int dev = 0, cus = 0, per_cu = 0;
        hipGetDevice(&dev); hipDeviceGetAttribute(&cus, hipDeviceAttributeMultiprocessorCount, dev);
        if (hipFuncSetAttribute((const void*)hybrid_fwd, hipFuncAttributeMaxDynamicSharedMemorySize, LDS_BYTES) != hipSuccess) { fprintf(stderr, "kernel_launch: hipFuncSetAttribute failed\n"); grid = -1; return; }
        hipOccupancyMaxActiveBlocksPerMultiprocessor(&per_cu, (const void*)hybrid_fwd, NWAVES * 64, LDS_BYTES);
        (void)hipGetLastError();
        if (per_cu < 1) per_cu = 1;
        grid = cus * 1;
        if (grid <= 0) grid = 256;
    }
    if (grid < 0) return;
    if (hipMemsetAsync((char*)d_ws + WS_BAR, 0, XCD_BAR_WORDS * 4, stream) != hipSuccess) { fprintf(stderr, "kernel_launch: memset failed\n"); return; }
    Args a{};
    for (int i = 0; i < 23; ++i) a.in[i] = (const float*)d_in[i];
    a.out = (float*)d_out; a.ws = (unsigned char*)d_ws;
#if MK_SINGLE
    a.ph_lo = 0; a.ph_hi = NPHASE;
    void* kargs[] = {&a};
    hipError_t e = hipLaunchCooperativeKernel((const void*)hybrid_fwd, dim3(grid), dim3(NWAVES * 64), kargs, LDS_BYTES, stream);
    if (e != hipSuccess) fprintf(stderr, "cooperative launch failed: %s (grid %d)\n", hipGetErrorString(e), grid);
#else
    for (int ph = 0; ph < NPHASE; ++ph) {
        a.ph_lo = ph; a.ph_hi = ph + 1;
        hipLaunchKernelGGL(hybrid_fwd, dim3(grid), dim3(NWAVES * 64), LDS_BYTES, stream, a);
    }
#endif
}
```

```cpp
#include <hip/hip_runtime.h>
#include <hip/hip_cooperative_groups.h>
#include <cstdio>
#include <cstdint>
namespace cg = cooperative_groups;
namespace pg8 {
#define PG8_LAS __attribute__((address_space(3)))
typedef unsigned short bf16_t;
typedef short bf16x8 __attribute__((ext_vector_type(8)));
typedef float f32x4 __attribute__((ext_vector_type(4)));
typedef unsigned u32x4 __attribute__((ext_vector_type(4)));
constexpr int BM = 256, BK = 64, HALF = 128, HTB = HALF * BK * 2  , STAGE_BYTES = 8 * HTB, NXCD = 8, WGM = 8;

__host__ __device__ __forceinline__ int lds_byte(int r, int c) { const int st = (r >> 4) * 2 + (c >> 5), rr = r & 15, cc = c & 31, ob = rr * 64 + cc * 2; return st * 1024 + (ob ^ (((ob >> 9) & 1) << 5)); }
__host__ __device__ __forceinline__ void stage_rc(int b, int& R, int& C) { const int st = b / 1024, sb = b % 1024, swz = sb ^ (((sb >> 9) & 1) << 5); R = (st >> 1) * 16 + swz / 64; C = (st & 1) * 32 + (swz % 64) / 2; }
__host__ __device__ __forceinline__ int perm32(int rho) { const int n = rho >> 4, i = rho & 15; return 8 * (i >> 2) + 4 * n + (i & 3); }

struct Unit { int pm, pn; };
struct Gemm { const bf16_t* A; const bf16_t* Bt; int M, N, K; };

struct StaticOrder {
    int nM, nN, nwg, G, c;
    __host__ __device__ void init(int M, int N, int G_, int c_) { nM = M / BM; nN = N / BM; nwg = nM * nN; G = G_; c = c_; }
    __host__ __device__ bool next(int i, Unit& u) const {
        const long L = (long)i * G + c; if (L >= nwg) return false;
        int wgid = (int)L; { const int q = nwg / NXCD, r = nwg % NXCD, xcd = wgid % NXCD, off = wgid / NXCD; wgid = (xcd < r ? xcd * (q + 1) : r * (q + 1) + (xcd - r) * q) + off; }
        const int nig = WGM * nN, gid = wgid / nig, fm = gid * WGM, gsz = (nM - fm) < WGM ? (nM - fm) : WGM;
        u.pm = fm + ((wgid % nig) % gsz); u.pn = (wgid % nig) / gsz; return true;
    }
    __device__ __forceinline__ void a_ready(const Unit&) const {}
    __device__ __forceinline__ void done(const Unit&) const {}
};

__device__ __forceinline__ unsigned cvt_pk_bf16(float lo, float hi) { unsigned r; asm volatile("v_cvt_pk_bf16_f32 %0, %1, %2" : "=v"(r) : "v"(lo), "v"(hi)); return r; }
typedef float f32x2 __attribute__((ext_vector_type(2)));
template <class Epi, class Sched, bool ALIGN_EPI = false, bool SP2 = false>
__device__ __forceinline__ void gemm_phase(PG8_LAS unsigned char* lds, const Gemm g, const Sched& S, const Epi& E, const int wid) {
    int lane; asm volatile("v_mbcnt_lo_u32_b32 %0, -1, 0\n\tv_mbcnt_hi_u32_b32 %0, -1, %0" : "=v"(lane));
    const int tid = wid * 64 + lane, wr = wid >> 2, wc = wid & 3, fr = lane & 15, fq = lane >> 4;
    const int K = g.K, nt = K / BK;
    unsigned voffA[2], voffB[2];
#pragma unroll
    for (int i = 0; i < 2; ++i) { int R, C; stage_rc(tid * 16 + i * 8192, R, C); const int Rb = Epi::PERM ? ((R & ~31) + perm32(R & 31)) : R;
        voffA[i] = (unsigned)(R * K + C) * 2u; voffB[i] = (unsigned)(Rb * K + C) * 2u; }
    const size_t kstep = (size_t)(BK * 2);
    const size_t hstep = (size_t)HALF * K * 2;
    const size_t tstep = 2 * hstep;
    const unsigned ldsw = (unsigned)wid * 1024u;
    const int aoff = lds_byte(wr * 64 + fr, fq * 8), boff = lds_byte(wc * 32 + fr, fq * 8);
#define PG8_SA(b, h) (((b) * 2 + (h)) * HTB)
#define PG8_SB(b, h) ((4 + (b) * 2 + (h)) * HTB)
#define PG8_STAGE(bufoff, gbase, voff) do { _Pragma("unroll") for (int _i = 0; _i < 2; ++_i) \
        __builtin_amdgcn_global_load_lds((const unsigned*)((const char*)(gbase) + (voff)[_i]), (PG8_LAS unsigned*)(lds + (bufoff) + ldsw + _i * 8192), 16, 0, 0); } while (0)
#define PG8_LDA(dst, b, h) do { _Pragma("unroll") for (int m = 0; m < 4; ++m) _Pragma("unroll") for (int k = 0; k < 2; ++k) dst[m][k] = *(const PG8_LAS bf16x8*)(lds + PG8_SA(b, h) + aoff + m * 2048 + k * 1024); } while (0)
#define PG8_LDB(dst, b, h) do { _Pragma("unroll") for (int n = 0; n < 2; ++n) _Pragma("unroll") for (int k = 0; k < 2; ++k) dst[n][k] = *(const PG8_LAS bf16x8*)(lds + PG8_SB(b, h) + boff + n * 2048 + k * 1024); } while (0)
#define PG8_MMA(ai, bj, At, Bt) do { __builtin_amdgcn_s_setprio(1); _Pragma("unroll") for (int m = 0; m < 4; ++m) _Pragma("unroll") for (int n = 0; n < 2; ++n) _Pragma("unroll") for (int k = 0; k < 2; ++k) \
        acc[ai][bj][m][n] = __builtin_amdgcn_mfma_f32_16x16x32_bf16(Bt[n][k], At[m][k], acc[ai][bj][m][n], 0, 0, 0); __builtin_amdgcn_s_setprio(0); } while (0)
#define PG8_WAIT_V(n) asm volatile("s_waitcnt vmcnt(" #n ")" ::: "memory")
#define PG8_WAIT_L(n) asm volatile("s_waitcnt lgkmcnt(" #n ")" ::: "memory")
#define PG8_BAR __builtin_amdgcn_s_barrier()
#define PG8_SCHED __builtin_amdgcn_sched_barrier(0)
    Unit cur, nxt; int ui = 0;
    if (!S.next(0, cur)) return;
    f32x4 acc[2][2][4][2];
#pragma unroll
    for (int a = 0; a < 2; ++a)
#pragma unroll
        for (int b = 0; b < 2; ++b)
#pragma unroll
            for (int m = 0; m < 4; ++m)
#pragma unroll
                for (int n = 0; n < 2; ++n) acc[a][b][m][n] = (f32x4){0.f, 0.f, 0.f, 0.f};
    bf16x8 At[4][2], B0[2][2], B1[2][2];
    const char* cA = (const char*)g.A + (size_t)cur.pm * tstep; const char* cB = (const char*)g.Bt + (size_t)cur.pn * tstep;
    S.a_ready(cur);
    if constexpr (SP2) {
        PG8_STAGE(PG8_SB(0, 0), cB, voffB); PG8_STAGE(PG8_SB(0, 1), cB + hstep, voffB); PG8_STAGE(PG8_SA(0, 0), cA, voffA); PG8_STAGE(PG8_SA(0, 1), cA + hstep, voffA);
        if (wr == 1) PG8_BAR;
        PG8_WAIT_V(2); PG8_BAR;
        PG8_STAGE(PG8_SB(1, 0), cB + kstep, voffB); PG8_STAGE(PG8_SA(1, 0), cA + kstep, voffA); PG8_STAGE(PG8_SB(1, 1), cB + hstep + kstep, voffB);
        PG8_WAIT_V(6); PG8_BAR;
    } else {
        PG8_STAGE(PG8_SB(0, 0), cB, voffB); PG8_STAGE(PG8_SA(0, 0), cA, voffA); PG8_STAGE(PG8_SB(0, 1), cB + hstep, voffB); PG8_STAGE(PG8_SA(0, 1), cA + hstep, voffA);
        if (wr == 1) PG8_BAR;
        PG8_WAIT_V(4); PG8_BAR;
        PG8_STAGE(PG8_SB(1, 0), cB + kstep, voffB); PG8_STAGE(PG8_SA(1, 0), cA + kstep, voffA); PG8_STAGE(PG8_SB(1, 1), cB + hstep + kstep, voffB);
        PG8_WAIT_V(6); PG8_BAR;
    }
    for (;;) {
        const bool has_next = S.next(ui + 1, nxt);
        const char* nA = has_next ? (const char*)g.A + (size_t)nxt.pm * tstep : cA; const char* nB = has_next ? (const char*)g.Bt + (size_t)nxt.pn * tstep : cB;
        for (int t = 0; t < nt; t += 2) {
            const bool last = (t == nt - 2);
            const char* a1 = cA + (size_t)(t + 1) * kstep;
            const char* a2 = last ? nA : cA + (size_t)(t + 2) * kstep; const char* b2 = last ? nB : cB + (size_t)(t + 2) * kstep;
            const char* a3 = a2 + kstep; const char* b3 = b2 + kstep;
            if (last && has_next) S.a_ready(nxt);
            if constexpr (SP2) {
            PG8_LDB(B0, 0, 0); PG8_LDB(B1, 0, 1); PG8_SCHED; PG8_LDA(At, 0, 0); PG8_STAGE(PG8_SA(1, 1), a1 + hstep, voffA);
            PG8_WAIT_V(8); PG8_WAIT_L(0); PG8_BAR; PG8_MMA(0, 0, At, B0); PG8_MMA(0, 1, At, B1); PG8_BAR; PG8_SCHED;
            PG8_LDA(At, 0, 1); PG8_STAGE(PG8_SB(0, 0), b2, voffB); PG8_STAGE(PG8_SB(0, 1), b2 + hstep, voffB); PG8_STAGE(PG8_SA(0, 0), a2, voffA);
            PG8_WAIT_V(8); PG8_WAIT_L(0); PG8_BAR; PG8_MMA(1, 0, At, B0); PG8_MMA(1, 1, At, B1); PG8_BAR; PG8_SCHED;
            PG8_LDB(B0, 1, 0); PG8_LDB(B1, 1, 1); PG8_SCHED; PG8_LDA(At, 1, 0); PG8_STAGE(PG8_SA(0, 1), a2 + hstep, voffA);
            PG8_WAIT_V(8); PG8_WAIT_L(0); PG8_BAR; PG8_MMA(0, 0, At, B0); PG8_MMA(0, 1, At, B1); PG8_BAR; PG8_SCHED;
            PG8_LDA(At, 1, 1); PG8_STAGE(PG8_SB(1, 0), b3, voffB); PG8_STAGE(PG8_SB(1, 1), b3 + hstep, voffB); PG8_STAGE(PG8_SA(1, 0), a3, voffA);
            PG8_WAIT_V(8); PG8_WAIT_L(0); PG8_BAR; PG8_MMA(1, 0, At, B0); PG8_MMA(1, 1, At, B1); PG8_BAR; PG8_SCHED;
            } else {
            PG8_LDB(B0, 0, 0); PG8_SCHED; PG8_LDA(At, 0, 0); PG8_STAGE(PG8_SA(1, 1), a1 + hstep, voffA);
            PG8_WAIT_L(8); PG8_BAR; PG8_WAIT_L(0); PG8_MMA(0, 0, At, B0); PG8_BAR; PG8_SCHED;
            PG8_LDB(B1, 0, 1); PG8_STAGE(PG8_SB(0, 0), b2, voffB);
            PG8_BAR; PG8_WAIT_L(0); PG8_MMA(0, 1, At, B1); PG8_BAR;
            PG8_LDA(At, 0, 1); PG8_STAGE(PG8_SA(0, 0), a2, voffA);
            PG8_BAR; PG8_WAIT_L(0); PG8_MMA(1, 0, At, B0); PG8_BAR; PG8_SCHED;
            PG8_STAGE(PG8_SB(0, 1), b2 + hstep, voffB);
            PG8_WAIT_V(6); PG8_BAR; PG8_MMA(1, 1, At, B1); PG8_BAR;
            PG8_LDB(B0, 1, 0); PG8_SCHED; PG8_LDA(At, 1, 0); PG8_STAGE(PG8_SA(0, 1), a2 + hstep, voffA);
            PG8_WAIT_L(8); PG8_BAR; PG8_WAIT_L(0); PG8_MMA(0, 0, At, B0); PG8_BAR; PG8_SCHED;
            PG8_LDB(B1, 1, 1); PG8_STAGE(PG8_SB(1, 0), b3, voffB);
            PG8_BAR; PG8_WAIT_L(0); PG8_MMA(0, 1, At, B1); PG8_BAR;
            PG8_LDA(At, 1, 1); PG8_STAGE(PG8_SA(1, 0), a3, voffA);
            PG8_BAR; PG8_WAIT_L(0); PG8_MMA(1, 0, At, B0); PG8_BAR; PG8_SCHED;
            PG8_STAGE(PG8_SB(1, 1), b3 + hstep, voffB);
            PG8_WAIT_V(6); PG8_BAR; PG8_MMA(1, 1, At, B1); PG8_BAR;
            }
        }
        if constexpr (ALIGN_EPI) { if (wr == 0) PG8_BAR; }
        if constexpr (!Epi::AFTER_DRAIN) { E(acc, cur, wr, wc, fr, fq); S.done(cur); }
        if (!has_next) break;
#pragma unroll
        for (int a = 0; a < 2; ++a)
#pragma unroll
            for (int b = 0; b < 2; ++b)
#pragma unroll
                for (int m = 0; m < 4; ++m)
#pragma unroll
                    for (int n = 0; n < 2; ++n) acc[a][b][m][n] = (f32x4){0.f, 0.f, 0.f, 0.f};
        cur = nxt; cA = nA; cB = nB; ++ui;
        if constexpr (ALIGN_EPI) { if (wr == 1) PG8_BAR; }
    }
    PG8_WAIT_V(0);
    if constexpr (!ALIGN_EPI) { if (wr == 0) PG8_BAR; }
    PG8_BAR;
    if constexpr (Epi::AFTER_DRAIN) { E.fused(acc, cur, wr, wc, fr, fq, lds, wid, lane); S.done(cur); }
#undef PG8_SA
#undef PG8_SB
#undef PG8_STAGE
#undef PG8_LDA
#undef PG8_LDB
#undef PG8_MMA
#undef PG8_WAIT_V
#undef PG8_WAIT_L
#undef PG8_BAR
#undef PG8_SCHED
}
}

namespace pg8 {
struct EpiStore {
    static constexpr bool PERM = true, AFTER_DRAIN = false;
    bf16_t* O; int ldc;
    __device__ __forceinline__ void operator()(const f32x4 (&acc)[2][2][4][2], const Unit& u, int wr, int wc, int fr, int fq) const {
        const int row0 = u.pm * BM + wr * 64 + fr; const int col0 = u.pn * BM + wc * 32 + 8 * fq;
#pragma unroll
        for (int ai = 0; ai < 2; ++ai)
#pragma unroll
            for (int m = 0; m < 4; ++m) { bf16_t* rowp = O + (size_t)(row0 + ai * HALF + m * 16) * ldc + col0;
#pragma unroll
                for (int bj = 0; bj < 2; ++bj) { const f32x4 v0 = acc[ai][bj][m][0], v1 = acc[ai][bj][m][1];
                    u32x4 w; w.x = cvt_pk_bf16(v0[0], v0[1]); w.y = cvt_pk_bf16(v0[2], v0[3]); w.z = cvt_pk_bf16(v1[0], v1[1]); w.w = cvt_pk_bf16(v1[2], v1[3]);
                    *(u32x4*)(rowp + bj * HALF) = w; } }
    }
};
struct EpiResid {
    static constexpr bool PERM = false, AFTER_DRAIN = false;
    const float* base; float* out; const float* gate;
    __device__ __forceinline__ void operator()(const f32x4 (&acc)[2][2][4][2], const Unit& u, int wr, int wc, int fr, int fq) const {
        const int row0 = u.pm * BM + wr * 64 + fr; const int col0 = u.pn * BM + wc * 32 + 4 * fq;
        const float* gb = gate + (size_t)((u.pm * BM) / 8192) * 3072 + col0;
        f32x4 gv[2][2];
#pragma unroll
        for (int bj = 0; bj < 2; ++bj)
#pragma unroll
            for (int n = 0; n < 2; ++n) gv[bj][n] = *(const f32x4*)(gb + bj * HALF + n * 16);
#pragma unroll
        for (int ai = 0; ai < 2; ++ai)
#pragma unroll
            for (int m = 0; m < 4; ++m) { const size_t off = (size_t)(row0 + ai * HALF + m * 16) * 1024 + col0;
#pragma unroll
                for (int bj = 0; bj < 2; ++bj)
#pragma unroll
                    for (int n = 0; n < 2; ++n) { const f32x4 bs = *(const f32x4*)(base + off + bj * HALF + n * 16);
                        *(f32x4*)(out + off + bj * HALF + n * 16) = bs + gv[bj][n] * acc[ai][bj][m][n]; } }
    }
};
}

typedef unsigned short bf16;
typedef short bf16x8 __attribute__((ext_vector_type(8)));
typedef float f32x4 __attribute__((ext_vector_type(4)));
typedef float f32x16 __attribute__((ext_vector_type(16)));
typedef unsigned u32x4 __attribute__((ext_vector_type(4)));
typedef unsigned u32x2 __attribute__((ext_vector_type(2)));
typedef float f32x2_t __attribute__((ext_vector_type(2)));
typedef __bf16 bf16x2_t __attribute__((ext_vector_type(2)));
#define LAS __attribute__((address_space(3)))

constexpr int NB = 4, S = 8192, D = 1024, M = NB * S;
constexpr int EIN = 3328, OIN = 4096, U1LD = 3072, EU = 2816;
constexpr int C_QA = 0, C_KA = 512, C_GA = 1024, C_QB = 1536, C_KB = 2048, C_VB = 2176, C_GB = 2304;
constexpr float LOG2E = 1.4426950408889634f;
constexpr float QS = 0.125f * LOG2E;
constexpr float EPS = 1e-6f;
constexpr int NWAVES = 8;

constexpr size_t MiB = 1u << 20;
constexpr size_t WS_BAR = 0;
constexpr size_t WS_MOD = 1 * MiB;
constexpr size_t WS_WINE = 2 * MiB, WS_WOUTE = 9 * MiB, WS_WINO = 11 * MiB, WS_WOUTO = 19 * MiB;
constexpr size_t WS_H = 32 * MiB;
constexpr size_t WS_VT = 96 * MiB;
constexpr size_t WS_U = 160 * MiB;
constexpr size_t WS_END = 416 * MiB;
constexpr int LDS_BYTES = 147456;
constexpr int LDS_SCR = 65536;
constexpr int LDS_MISC = 135168;

__device__ __forceinline__ unsigned cvtpk(float lo, float hi) { f32x2_t v = {lo, hi}; bf16x2_t b = __builtin_convertvector(v, bf16x2_t); return __builtin_bit_cast(unsigned, b); }
__device__ __forceinline__ float bf_lo(unsigned w) { return __uint_as_float(w << 16); }
__device__ __forceinline__ float bf_hi(unsigned w) { return __uint_as_float(w & 0xffff0000u); }
__device__ __forceinline__ float wave_sum(float v) {
#pragma unroll
    for (int o = 1; o < 64; o <<= 1) v += __shfl_xor(v, o);
    return v;
}
__device__ __forceinline__ float half_max(float m) { auto rr = __builtin_amdgcn_permlane32_swap(__float_as_uint(m), __float_as_uint(m), false, false); return fmaxf(__uint_as_float(rr[0]), __uint_as_float(rr[1])); }
__device__ __forceinline__ float half_sum(float m) { auto rr = __builtin_amdgcn_permlane32_swap(__float_as_uint(m), __float_as_uint(m), false, false); return __uint_as_float(rr[0]) + __uint_as_float(rr[1]); }
__device__ __forceinline__ int pi32(int i) { return (i & 0x13) | ((i & 8) >> 1) | ((i & 4) << 1); }
__device__ __forceinline__ float silu_f(float x) { return x * __builtin_amdgcn_rcpf(1.f + __expf(-x)); }
__device__ __forceinline__ int lane_now() { int l; asm volatile("v_mbcnt_lo_u32_b32 %0, -1, 0\n\tv_mbcnt_hi_u32_b32 %0, -1, %0" : "=v"(l)); return l; }
__device__ __forceinline__ void store_pair16(bf16* rowp16, u32x2 wk, u32x2 wk1) {
    auto r0 = __builtin_amdgcn_permlane32_swap(wk.x, wk1.x, false, false);
    auto r1 = __builtin_amdgcn_permlane32_swap(wk.y, wk1.y, false, false);
    u32x4 v; v.x = r0[0]; v.y = r1[0]; v.z = r0[1]; v.w = r1[1];
    *(u32x4*)rowp16 = v;
}
#define MFMA32(a, b, c) __builtin_amdgcn_mfma_f32_32x32x16_bf16((a), (b), (c), 0, 0, 0)

__device__ __forceinline__ void p0_silu_to_lds(const float* c, float* sc, int tid) {
#pragma unroll
    for (int i = 0; i < 8; ++i) { const float cb = c[tid + 512 * i]; sc[tid + 512 * i] = cb / (1.f + expf(-cb)); }
    __syncthreads();
}
__device__ __forceinline__ void p0_mod_item(const float* sc, const float* Wm, const float* bm, float* mod, int j0, float* red, int wid, int lane, int tid) {
    const int cl = lane & 31, kh = lane >> 5;
    float acc[4] = {0.f, 0.f, 0.f, 0.f};
#pragma unroll 16
    for (int i = 0; i < 64; ++i) {
        const int k = wid * 128 + 2 * i + kh; const float wv = Wm[(size_t)k * 3072 + j0 + cl];
#pragma unroll
        for (int b = 0; b < 4; ++b) acc[b] += sc[b * 1024 + k] * wv;
    }
#pragma unroll
    for (int b = 0; b < 4; ++b) acc[b] += __shfl_xor(acc[b], 32);
    if (lane < 32) {
#pragma unroll
        for (int b = 0; b < 4; ++b) red[(wid * 4 + b) * 32 + cl] = acc[b];
    }
    __syncthreads();
    if (tid < 128) { const int b = tid >> 5, c2 = tid & 31; float s = bm[j0 + c2];
#pragma unroll
        for (int w = 0; w < 8; ++w) s += red[(w * 4 + b) * 32 + c2];
        mod[b * 3072 + j0 + c2] = s; }
    __syncthreads();
}
__device__ __forceinline__ void p0_transpose_item(const float* W, int K, int N, bf16* WT, float* scr, int item, int lane, int nscale, float sc, int perm) {
    const int nblk = N / 32, kb = item / nblk, nb = item % nblk, k0 = 64 * kb, n0 = 32 * nb;
    int nd0 = n0;
    if (perm == 1) nd0 = (n0 < 2048 ? n0 : (n0 < 3072 ? n0 + 1024 : n0 - 1024));
    if (perm == 2) nd0 = (n0 < 1024 ? n0 : (n0 < 1536 ? n0 + 1792 : (n0 < 2688 ? n0 - 512 : n0 - 512)));
    const float f = (n0 < nscale) ? sc : 1.f;
#pragma unroll 8
    for (int i = 0; i < 32; ++i) { const int kk = 2 * i + (lane >> 5); scr[kk * 33 + (lane & 31)] = W[(size_t)(k0 + kk) * N + n0 + (lane & 31)] * f; }
    __builtin_amdgcn_wave_barrier();
    const int c = lane & 7;
#pragma unroll
    for (int j = 0; j < 4; ++j) { const int n = (lane >> 3) + 8 * j; const float* s = scr + (8 * c) * 33 + n;
        u32x4 o; o.x = cvtpk(s[0 * 33], s[1 * 33]); o.y = cvtpk(s[2 * 33], s[3 * 33]); o.z = cvtpk(s[4 * 33], s[5 * 33]); o.w = cvtpk(s[6 * 33], s[7 * 33]);
        *(u32x4*)(WT + (size_t)(nd0 + n) * K + k0 + 8 * c) = o; }
    __builtin_amdgcn_wave_barrier();
}

__device__ __forceinline__ void p_hrows(const float* X, bf16* H, const float* ng, const float* mod, int gw, int NGW, int lane) {
    for (int ch = gw; ch < M / 16; ch += NGW) {
        const int m0 = ch * 16, b = m0 / S; const float* mb = mod + b * 3072;
        f32x4 A[4], SH[4];
#pragma unroll
        for (int j = 0; j < 4; ++j) { const int col = 4 * lane + 256 * j; const f32x4 g = *(const f32x4*)(ng + col); const f32x4 sc = *(const f32x4*)(mb + 1024 + col); A[j] = g * (1.f + sc); SH[j] = *(const f32x4*)(mb + col); }
#pragma unroll 1
        for (int r0 = 0; r0 < 16; r0 += 4) {
            f32x4 v[4][4];
#pragma unroll
            for (int rr = 0; rr < 4; ++rr) { const float* xr = X + (size_t)(m0 + r0 + rr) * D;
#pragma unroll
                for (int j = 0; j < 4; ++j) v[rr][j] = *(const f32x4*)(xr + 4 * lane + 256 * j); }
#pragma unroll
            for (int rr = 0; rr < 4; ++rr) {
                float ss = 0.f;
#pragma unroll
                for (int j = 0; j < 4; ++j) ss += (v[rr][j].x * v[rr][j].x + v[rr][j].y * v[rr][j].y) + (v[rr][j].z * v[rr][j].z + v[rr][j].w * v[rr][j].w);
                ss = wave_sum(ss); const float rstd = 1.0f / sqrtf(ss * (1.f / D) + EPS);
                bf16* hr = H + (size_t)(m0 + r0 + rr) * D;
#pragma unroll
                for (int j = 0; j < 4; ++j) { const f32x4 o = v[rr][j] * rstd * A[j] + SH[j]; u32x2 w; w.x = cvtpk(o.x, o.y); w.y = cvtpk(o.z, o.w); *(u32x2*)(hr + 4 * lane + 256 * j) = w; }
            }
        }
    }
}

__device__ __forceinline__ void p_normrope(bf16* U, const int* pos, const float* aq, const float* ak, const float* bq, const float* bk, float* scr, int gw, int NGW, int lane) {
    const int sub = lane & 3, hsl = lane >> 2;
    const float invf = exp2f(-(float)(lane & 31) * (13.287712379549449f / 32.f));
    constexpr int NP = 1;
    int colp[NP]; float scp[NP]; bool validp[NP]; const float* gp[NP];
    { const int hs = hsl; validp[0] = hs < 10;
      if (hs < 8) { colp[0] = C_KA + 64 * hs; gp[0] = ak; scp[0] = 1.f; }
      else { colp[0] = C_KB + 64 * ((hs - 8) & 1); gp[0] = bk; scp[0] = 1.f; } }
    for (int ch = gw; ch < M / 16; ch += NGW) {
#pragma unroll 1
        for (int r0 = 0; r0 < 16; r0 += 4) {
            const int m0 = ch * 16 + r0;
            u32x4 xa[4][NP], xb[4][NP];
#pragma unroll
            for (int rr = 0; rr < 4; ++rr) { const bf16* ur = U + (size_t)(m0 + rr) * EU;
#pragma unroll
                for (int p = 0; p < NP; ++p) { xa[rr][p] = u32x4{0u, 0u, 0u, 0u}; xb[rr][p] = xa[rr][p];
                    if (validp[p]) { xa[rr][p] = *(const u32x4*)(ur + colp[p] + 8 * sub); xb[rr][p] = *(const u32x4*)(ur + colp[p] + 32 + 8 * sub); } } }
#pragma unroll
            for (int rr = 0; rr < 4; ++rr) {
                const float ang = (float)pos[m0 + rr] * invf;
                const float kq = rintf(ang * 0.15915494309189535f);
                float rd = fmaf(-kq, 6.28318548202514648f, ang); rd = fmaf(-kq, -1.74845553e-07f, rd);
                const float rv = rd * 0.15915494309189535f;
                scr[rr * 64 + lane] = (lane < 32) ? __builtin_amdgcn_cosf(rv) : __builtin_amdgcn_sinf(rv);
            }
            __builtin_amdgcn_wave_barrier();
#pragma unroll
            for (int rr = 0; rr < 4; ++rr) {
                float c8[8], s8[8];
#pragma unroll
                for (int i = 0; i < 8; ++i) { c8[i] = scr[rr * 64 + 8 * sub + i]; s8[i] = scr[rr * 64 + 32 + 8 * sub + i]; }
                bf16* ur = U + (size_t)(m0 + rr) * EU;
#pragma unroll
                for (int p = 0; p < NP; ++p) {
                    float x1[8], x2[8]; float ss = 0.f;
#pragma unroll
                    for (int i = 0; i < 4; ++i) { x1[2 * i] = bf_lo(xa[rr][p][i]); x1[2 * i + 1] = bf_hi(xa[rr][p][i]); x2[2 * i] = bf_lo(xb[rr][p][i]); x2[2 * i + 1] = bf_hi(xb[rr][p][i]); }
#pragma unroll
                    for (int i = 0; i < 8; ++i) ss += x1[i] * x1[i] + x2[i] * x2[i];
                    ss += __shfl_xor(ss, 1); ss += __shfl_xor(ss, 2);
                    const float rstd = 1.0f / sqrtf(ss * (1.f / 64.f) + EPS);
                    const float* g = gp[p]; const float sc = scp[p];
                    float o1[8], o2[8];
#pragma unroll
                    for (int i = 0; i < 8; ++i) { const float y1 = x1[i] * rstd * g[8 * sub + i], y2 = x2[i] * rstd * g[32 + 8 * sub + i];
                        o1[i] = (y1 * c8[i] - y2 * s8[i]) * sc; o2[i] = (y2 * c8[i] + y1 * s8[i]) * sc; }
                    if (validp[p]) { u32x4 wa, wb;
#pragma unroll
                        for (int i = 0; i < 4; ++i) { wa[i] = cvtpk(o1[2 * i], o1[2 * i + 1]); wb[i] = cvtpk(o2[2 * i], o2[2 * i + 1]); }
                        *(u32x4*)(ur + colp[p] + 8 * sub) = wa; *(u32x4*)(ur + colp[p] + 32 + 8 * sub) = wb; }
                }
            }
            __builtin_amdgcn_wave_barrier();
        }
    }
}

__device__ __forceinline__ void p_vt_item(const bf16* U, int ldu, int colbase, bf16* VT, int NC, int cdst0, int b, int s0, unsigned* scr, int lane) {
#pragma unroll
    for (int i = 0; i < 8; ++i) { const int row = i * 8 + (lane >> 3), ch = lane & 7;
        const u32x4 v = *(const u32x4*)(U + (size_t)(b * S + s0 + row) * ldu + colbase + 8 * ch);
        scr[row * 33 + 4 * ch + 0] = v.x; scr[row * 33 + 4 * ch + 1] = v.y; scr[row * 33 + 4 * ch + 2] = v.z; scr[row * 33 + 4 * ch + 3] = v.w; }
    __builtin_amdgcn_wave_barrier();
#pragma unroll
    for (int i = 0; i < 8; ++i) { const int c = i * 8 + (lane >> 3), ch = lane & 7; const int sh = (c & 1) * 16;
        unsigned hv[8];
#pragma unroll
        for (int k = 0; k < 8; ++k) hv[k] = (scr[(8 * ch + k) * 33 + (c >> 1)] >> sh) & 0xffffu;
        u32x4 o; o.x = hv[0] | (hv[1] << 16); o.y = hv[2] | (hv[3] << 16); o.z = hv[4] | (hv[5] << 16); o.w = hv[6] | (hv[7] << 16);
        *(u32x4*)(VT + (size_t)(b * NC + cdst0 + c) * S + s0 + 8 * ch) = o; }
    __builtin_amdgcn_wave_barrier();
}

constexpr int KROW = 144;
constexpr int KBUF_BYTES = 64 * KROW;
constexpr int VBUF128_BYTES = 128 * KROW;
constexpr int DK_BYTES = 8192, DV_BYTES = 16384;

__device__ __forceinline__ void qk_tile(f32x16& s0, f32x16& s1, const unsigned char* Kb, const bf16x8 (&qf)[4], int prow, int hi) {
    const unsigned char* k0 = Kb + prow * KROW + hi * 16;
    s0 = f32x16{}; s1 = f32x16{};
#pragma unroll
    for (int ks = 0; ks < 4; ++ks) {
        const bf16x8 a0 = *(const bf16x8*)(k0 + ks * 32), a1 = *(const bf16x8*)(k0 + 32 * KROW + ks * 32);
        s0 = MFMA32(a0, qf[ks], s0); s1 = MFMA32(a1, qf[ks], s1);
    }
}
__device__ __forceinline__ bf16x8 pack8(const f32x16& p, int base) {
    u32x4 w; w.x = cvtpk(p[base], p[base + 1]); w.y = cvtpk(p[base + 2], p[base + 3]); w.z = cvtpk(p[base + 4], p[base + 5]); w.w = cvtpk(p[base + 6], p[base + 7]);
    return __builtin_bit_cast(bf16x8, w);
}
template <int NDB>
__device__ __forceinline__ void sm_update(f32x16& s0, f32x16& s1, float& m, float& l, f32x16 (&o)[NDB], bf16x8 (&pk)[4]) {
    float mx = fmaxf(s0[0], s1[0]);
#pragma unroll
    for (int r = 1; r < 16; ++r) mx = fmaxf(mx, fmaxf(s0[r], s1[r]));
    mx = half_max(mx);
    const float mn = fmaxf(m, mx);
    if (__any(mn > m)) {
        const float f = (mn > m) ? __builtin_amdgcn_exp2f(m - mn) : 1.f;
        l *= f;
#pragma unroll
        for (int db = 0; db < NDB; ++db)
#pragma unroll
            for (int r = 0; r < 16; ++r) o[db][r] *= f;
        m = mn;
    }
    float ps = 0.f;
#pragma unroll
    for (int r = 0; r < 16; ++r) { s0[r] = __builtin_amdgcn_exp2f(s0[r] - m); s1[r] = __builtin_amdgcn_exp2f(s1[r] - m); ps += s0[r] + s1[r]; }
    l += ps;
    pk[0] = pack8(s0, 0); pk[1] = pack8(s0, 8); pk[2] = pack8(s1, 0); pk[3] = pack8(s1, 8);
}


__device__ __forceinline__ void q_norm_rope(bf16x8 (&qf)[4], const float* gain, int pos, int hi_) {
    const int hi = lane_now() >> 5; (void)hi_;
    float x[4][8]; float ss = 0.f;
#pragma unroll
    for (int ks = 0; ks < 4; ++ks) { const u32x4 w = __builtin_bit_cast(u32x4, qf[ks]);
#pragma unroll
        for (int i = 0; i < 4; ++i) { x[ks][2 * i] = bf_lo(w[i]); x[ks][2 * i + 1] = bf_hi(w[i]); } }
#pragma unroll
    for (int ks = 0; ks < 4; ++ks)
#pragma unroll
        for (int j = 0; j < 8; ++j) ss += x[ks][j] * x[ks][j];
    ss = half_sum(ss);
    const float rstd = 1.0f / sqrtf(ss * (1.f / 64.f) + EPS);
    const float fpos = (float)pos;
#pragma unroll
    for (int ks = 0; ks < 2; ++ks) {
        const f32x4 ga = *(const f32x4*)(gain + 16 * ks + 8 * hi), gb = *(const f32x4*)(gain + 16 * ks + 8 * hi + 4);
        const f32x4 gc = *(const f32x4*)(gain + 32 + 16 * ks + 8 * hi), gd = *(const f32x4*)(gain + 32 + 16 * ks + 8 * hi + 4);
#pragma unroll
        for (int j = 0; j < 8; ++j) {
            const int d = 16 * ks + 8 * hi + j;
            const float invf = exp2f(-(float)d * (13.287712379549449f / 32.f));
            const float ang = fpos * invf;
            const float kq = rintf(ang * 0.15915494309189535f);
            float rd = fmaf(-kq, 6.28318548202514648f, ang); rd = fmaf(-kq, -1.74845553e-07f, rd);
            const float rv = rd * 0.15915494309189535f;
            const float cs = __builtin_amdgcn_cosf(rv), sn = __builtin_amdgcn_sinf(rv);
            const float g1 = (j < 4) ? ga[j & 3] : gb[j & 3], g2 = (j < 4) ? gc[j & 3] : gd[j & 3];
            const float y1 = x[ks][j] * rstd * g1, y2 = x[ks + 2][j] * rstd * g2;
            x[ks][j] = (y1 * cs - y2 * sn) * QS; x[ks + 2][j] = (y2 * cs + y1 * sn) * QS;
        }
    }
#pragma unroll
    for (int ks = 0; ks < 4; ++ks) { u32x4 w;
#pragma unroll
        for (int i = 0; i < 4; ++i) w[i] = cvtpk(x[ks][2 * i], x[ks][2 * i + 1]);
        qf[ks] = __builtin_bit_cast(bf16x8, w); }
}

#define SBAR() __builtin_amdgcn_sched_barrier(0)
#define PIN(x) asm volatile("" : "+v"(x))
__device__ __forceinline__ float max3f(float a, float b, float c) { float r; asm("v_max3_f32 %0, %1, %2, %3" : "=v"(r) : "v"(a), "v"(b), "v"(c)); return r; }
template <bool FIXM> __device__ __forceinline__ void diff_unit(int b, int h, int qb, float lam, const bf16* U, const bf16* VTa, bf16* Y, const float* subg, const float* qgain, const int* pos, unsigned char* lds, int tid, int wid, int lane) {
    lane = lane_now(); tid = wid * 64 + lane;
    const int r32 = lane & 31, hi = lane >> 5, prow = pi32(r32);
    const int q0 = qb * 256, t0 = q0 + 32 * wid, tq = t0 + r32;
    const size_t rowbase = (size_t)b * S;
    const int NT = 4 * qb + 4, mylast = 4 * qb + (wid >> 1);
    f32x16 o[4];
#pragma unroll 1
    for (int c = 0; c < 2; ++c) {
        LAS unsigned char* qlds = (LAS unsigned char*)lds + 98304 + wid * 4096 + lane * 16;
        { const bf16* qp = U + (rowbase + tq) * EU + C_QA + (2 * h + c) * 64 + hi * 8; bf16x8 qraw[4];
#pragma unroll
          for (int ks = 0; ks < 4; ++ks) qraw[ks] = *(const bf16x8*)(qp + ks * 16);
          q_norm_rope(qraw, qgain, pos[rowbase + tq], hi);
#pragma unroll
          for (int ks = 0; ks < 4; ++ks) *(LAS bf16x8*)(qlds + ks * 1024) = qraw[ks]; }
#define QF(ks) (*(const LAS bf16x8*)(qlds + (ks) * 1024))
        const int srow = 8 * wid + (lane >> 3), sch = (lane & 7) ^ ((srow >> 1) & 7);
        const char* kb_u = (const char*)(U + rowbase * EU + C_KA + (2 * h + c) * 64);
        const char* vb_u = (const char*)(VTa + (size_t)(h * 128) * M + rowbase);
        const unsigned koff = (unsigned)(srow * EU + 8 * sch) * 2u, voff = (unsigned)(srow * M + 8 * sch) * 2u;
        LAS unsigned char* ldsl = (LAS unsigned char*)lds + wid * 1024;
#define DMA_K(t_, slot_) __builtin_amdgcn_global_load_lds((const unsigned*)(kb_u + (size_t)(t_) * (64 * EU * 2) + koff), (LAS unsigned*)(ldsl + (slot_) * DK_BYTES), 16, 0, 0)
#define DMA_V(t_, slot_) do { __builtin_amdgcn_global_load_lds((const unsigned*)(vb_u + (size_t)(t_) * 128 + voff), (LAS unsigned*)(ldsl + 4 * DK_BYTES + (slot_) * DV_BYTES), 16, 0, 0); \
                             __builtin_amdgcn_global_load_lds((const unsigned*)(vb_u + (size_t)(t_) * 128 + (size_t)64 * M * 2 + voff), (LAS unsigned*)(ldsl + 4 * DK_BYTES + (slot_) * DV_BYTES + 8192), 16, 0, 0); } while (0)
#define DMA_GROUP(t_) do { const int kt_ = ((t_) + 3 < NT) ? (t_) + 3 : NT - 1; int vt_ = ((t_) + 2 < NT) ? (t_) + 2 : NT - 1; vt_ = vt_ < 0 ? 0 : vt_; DMA_K(kt_, ((t_) + 3) & 3); DMA_V(vt_, ((t_) + 2) & 3); } while (0)
        DMA_GROUP(-3); DMA_GROUP(-2); DMA_GROUP(-1);
        asm volatile("s_waitcnt vmcnt(6)" ::: "memory");
        __builtin_amdgcn_s_barrier();
        float m = -INFINITY, l = 0.f;
#pragma unroll
        for (int db = 0; db < 4; ++db) o[db] = f32x16{};
        u32x4 pwA[4], pwB[4];
#pragma unroll
        for (int i = 0; i < 4; ++i) { pwA[i] = u32x4{0u, 0u, 0u, 0u}; pwB[i] = pwA[i]; }
        const LAS unsigned char* kfp = (const LAS unsigned char*)lds + prow * 128; const LAS unsigned char* vfp = (const LAS unsigned char*)lds + 4 * DK_BYTES + r32 * 128;
        unsigned kofs[4], vofs[4];
#pragma unroll
        for (int k4 = 0; k4 < 4; ++k4) { kofs[k4] = ((2 * k4 + hi) ^ ((prow >> 1) & 7)) * 16; vofs[k4] = ((2 * k4 + hi) ^ ((r32 >> 1) & 7)) * 16; }
#define KFRAG(Kb, i) (*(const LAS bf16x8*)((Kb) + ((i) & 1) * 4096 + kofs[(i) >> 1]))
#define VFRAG(Vb, j) (*(const LAS bf16x8*)((Vb) + ((j) & 3) * 4096 + vofs[(j) >> 2]))
#define DQK(T_) \
                f32x16 n0 = f32x16{}, n1 = f32x16{}; \
                { const LAS unsigned char* Kb = kfp + ((T_) & 3) * DK_BYTES; bf16x8 kf[2], qr[2]; \
                  _Pragma("unroll") for (int i = 0; i < 2; ++i) { kf[i] = KFRAG(Kb, i); qr[i] = QF(i); } \
                  SBAR(); \
                  _Pragma("unroll") for (int i = 0; i < 8; ++i) { \
                      if (i & 1) n1 = MFMA32(kf[i & 1], qr[(i >> 1) & 1], n1); else n0 = MFMA32(kf[i & 1], qr[(i >> 1) & 1], n0); \
                      if (i + 2 < 8) kf[i & 1] = KFRAG(Kb, i + 2); \
                      if ((i & 1) && (i >> 1) + 2 < 4) qr[(i >> 1) & 1] = QF((i >> 1) + 2); \
                      SBAR(); } } \
                if ((T_) == mylast) { \
                    int tqm = tq - 64 * (T_) - 8 * hi; asm volatile("" : "+v"(tqm)); \
                    _Pragma("unroll") for (int r = 0; r < 16; ++r) { const int key = 16 * (r >> 3) + (r & 7); if (key > tqm) n0[r] = -INFINITY; if (key + 32 > tqm) n1[r] = -INFINITY; } \
                } \
                bool resc = false; float mn = 0.f, f = 1.f; \
                if (!FIXM) { \
                    asm volatile("s_nop 15\n\ts_nop 7" : "+v"(n0), "+v"(n1));     \
                    float mx = max3f(n0[0], n1[0], n0[1]), mx2 = max3f(n1[1], n0[2], n1[2]); \
                    _Pragma("unroll") for (int r = 3; r < 15; r += 2) { mx = max3f(mx, n0[r], n1[r]); mx2 = max3f(mx2, n0[r + 1], n1[r + 1]); } \
                    mx = max3f(mx, n0[15], n1[15]); mx = fmaxf(mx, mx2); \
                    mx = half_max(mx); \
                    resc = __any(mx > m + 8.f); \
                    mn = resc ? fmaxf(m, mx) : m; \
                    f = (mn > m) ? __builtin_amdgcn_exp2f(m - mn) : 1.f; \
                    m = mn; } \
                float sacc = 0.f;
#define DEXP(j, PWN) { const float a0_ = ((j) < 8 ? n0[2 * ((j) & 7)] : n1[2 * ((j) & 7)]), a1_ = ((j) < 8 ? n0[2 * ((j) & 7) + 1] : n1[2 * ((j) & 7) + 1]); \
                      const float p0 = __builtin_amdgcn_exp2f(FIXM ? a0_ : a0_ - mn), p1 = __builtin_amdgcn_exp2f(FIXM ? a1_ : a1_ - mn); \
                      sacc += p0; sacc += p1; PWN[(j) >> 2][(j) & 3] = cvtpk(p0, p1); PIN(sacc); PIN(PWN[(j) >> 2]); }
#define DEND() asm volatile("s_waitcnt vmcnt(6) lgkmcnt(0)" ::: "memory"); __builtin_amdgcn_s_barrier();
#define DSTEP(T_, PWC, PWN) do { \
            DMA_GROUP(T_); \
            const LAS unsigned char* Vb = vfp + (((T_) - 1) & 3) * DV_BYTES; \
            if ((T_) <= mylast) { \
                DQK(T_) \
                bf16x8 vf[2]; \
                _Pragma("unroll") for (int j = 0; j < 2; ++j) vf[j] = VFRAG(Vb, j); \
                SBAR(); \
                _Pragma("unroll") for (int j = 0; j < 16; ++j) { \
                    o[j & 3] = MFMA32(vf[j & 1], __builtin_bit_cast(bf16x8, PWC[j >> 2]), o[j & 3]); \
                    if (j + 2 < 16) vf[j & 1] = VFRAG(Vb, j + 2); \
                    DEXP(j, PWN) \
                    SBAR(); } \
                if (resc) { l *= f; \
                    _Pragma("unroll") for (int db = 0; db < 4; ++db) _Pragma("unroll") for (int r = 0; r < 16; ++r) o[db][r] *= f; } \
                l += sacc; \
            } else if ((T_) - 1 <= mylast) { \
                _Pragma("unroll") for (int j = 0; j < 16; ++j) { const bf16x8 vf = VFRAG(Vb, j); o[j & 3] = MFMA32(vf, __builtin_bit_cast(bf16x8, PWC[j >> 2]), o[j & 3]); if ((j & 3) == 3) SBAR(); } \
            } \
            DEND() \
        } while (0)
        {
            DMA_GROUP(0);
            DQK(0)
#pragma unroll
            for (int j = 0; j < 16; ++j) DEXP(j, pwA)
            (void)resc; (void)f;
            l = sacc;
            DEND()
        }
#pragma unroll 1
        for (int t2 = 1; t2 <= NT; t2 += 2) {
            DSTEP(t2, pwA, pwB);
            if (t2 + 1 <= NT) DSTEP(t2 + 1, pwB, pwA);
        }
#undef DSTEP
#undef DQK
#undef DEXP
#undef DEND
        asm volatile("s_waitcnt vmcnt(0)" ::: "memory");
        __builtin_amdgcn_s_barrier();
#undef KFRAG
#undef VFRAG
#undef QF
#undef DMA_K
#undef DMA_V
#undef DMA_GROUP
        const float inv = 1.0f / half_sum(l);
        bf16* yst = Y + (rowbase + tq) * D + h * 128 + 8 * hi;
        if (c == 0) {
#pragma unroll
            for (int db = 0; db < 4; ++db)
#pragma unroll
                for (int p2 = 0; p2 < 2; ++p2) { u32x4 w;
#pragma unroll
                    for (int e = 0; e < 4; ++e) w[e] = cvtpk(o[db][8 * p2 + 2 * e] * inv, o[db][8 * p2 + 2 * e + 1] * inv);
                    *(u32x4*)(yst + 32 * db + 16 * p2) = w; }
        } else {
            const float li = lam * inv;
#pragma unroll
            for (int db = 0; db < 4; ++db)
#pragma unroll
                for (int p2 = 0; p2 < 2; ++p2) { const u32x4 w = *(const u32x4*)(yst + 32 * db + 16 * p2);
#pragma unroll
                    for (int e = 0; e < 4; ++e) { o[db][8 * p2 + 2 * e] = bf_lo(w[e]) - o[db][8 * p2 + 2 * e] * li; o[db][8 * p2 + 2 * e + 1] = bf_hi(w[e]) - o[db][8 * p2 + 2 * e + 1] * li; } }
        }
    }
    float ss = 0.f;
#pragma unroll
    for (int db = 0; db < 4; ++db)
#pragma unroll
        for (int r = 0; r < 16; ++r) ss += o[db][r] * o[db][r];
    ss = half_sum(ss);
    const float rstd = 0.8f / sqrtf(ss * (1.f / 128.f) + EPS);
    const int lane_e = lane_now();
    const int hi_e = lane_e >> 5, tq_e = t0 + (lane_e & 31);
    const bf16* gar = U + (rowbase + tq_e) * EU + C_GA + h * 128;
    bf16* yr = Y + (rowbase + tq_e) * D + h * 128; u32x2 wprev = {0u, 0u};
#pragma unroll
    for (int db = 0; db < 4; ++db)
#pragma unroll
        for (int g4 = 0; g4 < 4; ++g4) {
            const int e = 32 * db + 8 * g4 + 4 * hi_e;
            const u32x2 gw = *(const u32x2*)(gar + e); const f32x4 sg = *(const f32x4*)(subg + e);
            const float y0 = o[db][4 * g4 + 0] * rstd * sg.x * silu_f(bf_lo(gw.x)), y1 = o[db][4 * g4 + 1] * rstd * sg.y * silu_f(bf_hi(gw.x));
            const float y2 = o[db][4 * g4 + 2] * rstd * sg.z * silu_f(bf_lo(gw.y)), y3 = o[db][4 * g4 + 3] * rstd * sg.w * silu_f(bf_hi(gw.y));
            u32x2 w; w.x = cvtpk(y0, y1); w.y = cvtpk(y2, y3);
            if ((g4 & 1) == 0) wprev = w; else store_pair16(yr + 32 * db + 16 * (g4 >> 1) + 8 * hi_e, wprev, w);
        }
}

__device__ __forceinline__ void swa_unit(int b, int kvh, int qb, const bf16* U, const bf16* VTb, bf16* Y, const float* sinks, const float* qgain, const int* pos, unsigned char* lds, int wid, int lane) {
    const int r32 = lane & 31, hi = lane >> 5, prow = pi32(r32);
    const int q0 = qb * 256, t0 = q0 + 32 * wid, tq = t0 + r32;
    const size_t rowbase = (size_t)b * S;
    const int T0 = (q0 >= 128) ? (q0 - 128) >> 6 : 0, T1 = (q0 + 255) >> 6, nT = T1 - T0 + 1;
    {
        const int srow = 8 * wid + (lane >> 3), sch = (lane & 7) ^ ((srow >> 1) & 7);
        const char* kb_u = (const char*)(U + (rowbase + 64 * T0) * EU + C_KB + kvh * 64);
        const char* vb_u = (const char*)(VTb + ((size_t)(b * 128 + kvh * 64)) * S + 64 * T0);
        const unsigned koff = (unsigned)(srow * EU + 8 * sch) * 2u, voff = (unsigned)(srow * S + 8 * sch) * 2u;
        LAS unsigned char* ldsl = (LAS unsigned char*)lds + wid * 1024;
#pragma unroll 1
        for (int s = 0; s < nT; ++s) {
            __builtin_amdgcn_global_load_lds((const unsigned*)(kb_u + (size_t)s * (64 * EU * 2) + koff), (LAS unsigned*)(ldsl + s * 8192), 16, 0, 0);
            __builtin_amdgcn_global_load_lds((const unsigned*)(vb_u + (size_t)s * 128 + voff), (LAS unsigned*)(ldsl + 49152 + s * 8192), 16, 0, 0);
        }
        asm volatile("s_waitcnt vmcnt(0)" ::: "memory");
        __syncthreads();
    }
    const LAS unsigned char* kfp = (const LAS unsigned char*)lds + prow * 128; const LAS unsigned char* vfp = (const LAS unsigned char*)lds + 49152 + r32 * 128;
    unsigned kofs[4], vofs[4];
#pragma unroll
    for (int k4 = 0; k4 < 4; ++k4) { kofs[k4] = ((2 * k4 + hi) ^ ((prow >> 1) & 7)) * 16; vofs[k4] = ((2 * k4 + hi) ^ ((r32 >> 1) & 7)) * 16; }
    const int tlo = (t0 >= 127) ? (t0 - 127) >> 6 : 0, thi = (t0 + 31) >> 6;
#pragma unroll 1
    for (int g = 0; g < 4; ++g) {
        const int qh = kvh * 4 + g;
        bf16x8 qf[4];
        { const bf16* qp = U + (rowbase + tq) * EU + C_QB + qh * 64 + hi * 8;
#pragma unroll
          for (int ks = 0; ks < 4; ++ks) qf[ks] = *(const bf16x8*)(qp + ks * 16); }
        q_norm_rope(qf, qgain, pos[rowbase + tq], hi);
        float m = sinks[qh] * LOG2E, l = (hi == 0) ? 1.f : 0.f;
        f32x16 o[2]; o[0] = f32x16{}; o[1] = f32x16{};
#pragma unroll 1
        for (int t = tlo; t <= thi; ++t) {
            const LAS unsigned char* Kb = kfp + (t - T0) * 8192; const LAS unsigned char* Vb = vfp + (t - T0) * 8192;
            f32x16 s0 = f32x16{}, s1 = f32x16{};
#pragma unroll
            for (int ks = 0; ks < 4; ++ks) { const bf16x8 a0 = *(const LAS bf16x8*)(Kb + kofs[ks]), a1 = *(const LAS bf16x8*)(Kb + 4096 + kofs[ks]); s0 = MFMA32(a0, qf[ks], s0); s1 = MFMA32(a1, qf[ks], s1); }
            const int rel = tq - 64 * t - 8 * hi;
#pragma unroll
            for (int r = 0; r < 16; ++r) { const int key = 16 * (r >> 3) + (r & 7);
                if (key > rel || rel - key >= 128) s0[r] = -INFINITY;
                if (key + 32 > rel || rel - (key + 32) >= 128) s1[r] = -INFINITY; }
            bf16x8 pk[4]; sm_update<2>(s0, s1, m, l, o, pk);
#pragma unroll
            for (int db = 0; db < 2; ++db)
#pragma unroll
                for (int kk = 0; kk < 4; ++kk) { const bf16x8 vf = *(const LAS bf16x8*)(Vb + db * 4096 + vofs[kk]); o[db] = MFMA32(vf, pk[kk], o[db]); }
        }
        const float inv = 1.0f / half_sum(l);
        const bf16* gbr = U + (rowbase + tq) * EU + C_GB + qh * 64;
        bf16* yr = Y + (rowbase + tq) * D + 512 + qh * 64; u32x2 wprev = {0u, 0u};
#pragma unroll
        for (int db = 0; db < 2; ++db)
#pragma unroll
            for (int g4 = 0; g4 < 4; ++g4) {
                const int e = 32 * db + 8 * g4 + 4 * hi;
                const u32x2 gw = *(const u32x2*)(gbr + e);
                const float y0 = o[db][4 * g4 + 0] * inv * silu_f(bf_lo(gw.x)), y1 = o[db][4 * g4 + 1] * inv * silu_f(bf_hi(gw.x));
                const float y2 = o[db][4 * g4 + 2] * inv * silu_f(bf_lo(gw.y)), y3 = o[db][4 * g4 + 3] * inv * silu_f(bf_hi(gw.y));
                u32x2 w; w.x = cvtpk(y0, y1); w.y = cvtpk(y2, y3);
                if ((g4 & 1) == 0) wprev = w; else store_pair16(yr + 32 * db + 16 * (g4 >> 1) + 8 * hi, wprev, w);
            }
    }
    __syncthreads();
}

__device__ __forceinline__ void sb_unit(int b, int h, int qb, const bf16* U, const bf16* VT, bf16* Y, unsigned char* lds, int wid, int lane, int& res_lo, int& res_hi) {
    lane = lane_now();
    const int r32 = lane & 31, hi = lane >> 5, prow = pi32(r32);
    const int q0 = qb * 256, t0 = q0 + 32 * wid, tq = t0 + r32;
    const size_t rowbase = (size_t)b * S;
    const int mytile = 4 * qb + (wid >> 1);
    bf16x8 TM[2], JN;
#pragma unroll
    for (int s2 = 0; s2 < 2; ++s2)
#pragma unroll
        for (int j = 0; j < 8; ++j) TM[s2][j] = (16 * s2 + 8 * hi + j > prow) ? (short)0xBF80 : (short)0;
#pragma unroll
    for (int j = 0; j < 8; ++j) JN[j] = (short)0xBF80;
    bf16x8 qf[4];
    { const bf16* qp = U + (rowbase + tq) * U1LD + h * 64 + hi * 8;
#pragma unroll
      for (int ks = 0; ks < 4; ++ks) qf[ks] = *(const bf16x8*)(qp + ks * 16); }
    u32x2 gwv[2][4];
    { const bf16* gr0 = U + (rowbase + tq) * U1LD + 2048 + h * 64 + 4 * hi;
#pragma unroll
      for (int db = 0; db < 2; ++db)
#pragma unroll
          for (int g4 = 0; g4 < 4; ++g4) gwv[db][g4] = *(const u32x2*)(gr0 + 32 * db + 8 * g4); }
    const int srow = 8 * wid + (lane >> 3), sch = (lane & 7) ^ ((srow >> 1) & 7);
    const char* kb_u = (const char*)(U + rowbase * U1LD + 1024 + h * 64);
    const char* vb_u = (const char*)(VT + (size_t)(h * 64) * M + rowbase);
    const unsigned koff = (unsigned)(srow * U1LD + 8 * sch) * 2u, voff = (unsigned)(srow * M + 8 * sch) * 2u;
    LAS unsigned char* ldsl = (LAS unsigned char*)lds + wid * 1024;
    const LAS unsigned char* kfp = (const LAS unsigned char*)lds + prow * 128; const LAS unsigned char* vfp = (const LAS unsigned char*)lds + 8192 + r32 * 128;
    unsigned kofs[4], vofs[4];
#pragma unroll
    for (int k4 = 0; k4 < 4; ++k4) { kofs[k4] = ((2 * k4 + hi) ^ ((prow >> 1) & 7)) * 16; vofs[k4] = ((2 * k4 + hi) ^ ((r32 >> 1) & 7)) * 16; }
    f32x16 C = f32x16{}; f32x16 o[2]; o[0] = f32x16{}; o[1] = f32x16{};
    bool alive = true;
    volatile unsigned* flg = (volatile unsigned*)(lds + LDS_MISC + 128);
#pragma unroll 1
    for (int top = 4 * qb + 3; ; top -= 7) {
        const int lo = (top >= 6) ? top - 6 : 0;
#pragma unroll 1
        for (int t = top; t >= lo; --t) {
            if (t >= res_lo && t <= res_hi) continue;
            __builtin_amdgcn_global_load_lds((const unsigned*)(kb_u + (size_t)t * (64 * U1LD * 2) + koff), (LAS unsigned*)(ldsl + (t & 7) * 16384), 16, 0, 0);
            __builtin_amdgcn_global_load_lds((const unsigned*)(vb_u + (size_t)t * 128 + voff), (LAS unsigned*)(ldsl + (t & 7) * 16384 + 8192), 16, 0, 0);
        }
        { const int nh = (res_hi < lo + 7) ? res_hi : lo + 7; res_hi = (nh > top) ? nh : top; res_lo = lo; if (res_hi > lo + 7) res_hi = lo + 7; }
        asm volatile("s_waitcnt vmcnt(0)" ::: "memory");
        __syncthreads();
#pragma unroll 1
        for (int t = (top < mytile ? top : mytile); t >= lo && alive; --t) {
            const LAS unsigned char* Kb = kfp + (t & 7) * 16384; const LAS unsigned char* Vb = vfp + (t & 7) * 16384;
            f32x16 y0 = f32x16{}, y1 = f32x16{};
#pragma unroll
            for (int ks = 0; ks < 4; ++ks) { const bf16x8 a0 = *(const LAS bf16x8*)(Kb + kofs[ks]), a1 = *(const LAS bf16x8*)(Kb + 4096 + kofs[ks]); y0 = MFMA32(a0, qf[ks], y0); y1 = MFMA32(a1, qf[ks], y1); }
#pragma unroll
            for (int r = 0; r < 16; ++r) { y0[r] = fminf(y0[r], 100.f); y1[r] = fminf(y1[r], 100.f); }
            if (t == mytile) {
                int tqm = tq - 64 * t - 8 * hi; asm volatile("" : "+v"(tqm));
#pragma unroll
                for (int r = 0; r < 16; ++r) { const int key = 16 * (r >> 3) + (r & 7); if (key >= tqm) y0[r] = -INFINITY; if (key + 32 >= tqm) y1[r] = -INFINITY; }
            }
            f32x16 l0, l1;
#pragma unroll
            for (int r = 0; r < 16; ++r) { l0[r] = __builtin_amdgcn_logf(1.f + __builtin_amdgcn_exp2f(y0[r])); l1[r] = __builtin_amdgcn_logf(1.f + __builtin_amdgcn_exp2f(y1[r])); }
            bf16x8 lb[4]; lb[0] = pack8(l0, 0); lb[1] = pack8(l0, 8); lb[2] = pack8(l1, 0); lb[3] = pack8(l1, 8);
#pragma unroll
            for (int r = 0; r < 16; ++r) { y0[r] -= l0[r]; y1[r] -= l1[r]; }
            f32x16 X = MFMA32(JN, lb[2], C); X = MFMA32(JN, lb[3], X);
            f32x16 f1 = MFMA32(TM[0], lb[2], C); f1 = MFMA32(TM[1], lb[3], f1);
            f32x16 f0 = MFMA32(TM[0], lb[0], X); f0 = MFMA32(TM[1], lb[1], f0);
            C = MFMA32(JN, lb[0], X); C = MFMA32(JN, lb[1], C);
#pragma unroll
            for (int r = 0; r < 16; ++r) { y0[r] = __builtin_amdgcn_exp2f(y0[r] + f0[r]); y1[r] = __builtin_amdgcn_exp2f(y1[r] + f1[r]); }
            bf16x8 pk[4]; pk[0] = pack8(y0, 0); pk[1] = pack8(y0, 8); pk[2] = pack8(y1, 0); pk[3] = pack8(y1, 8);
#pragma unroll
            for (int db = 0; db < 2; ++db)
#pragma unroll
                for (int kk = 0; kk < 4; ++kk) { const bf16x8 vf = *(const LAS bf16x8*)(Vb + db * 4096 + vofs[kk]); o[db] = MFMA32(vf, pk[kk], o[db]); }
            alive = __any(C[0] > -160.f);
        }
        if (lo == 0) break;
        if (lane == 0) flg[wid] = alive ? 1u : 0u;
        __syncthreads();
        const bool any_alive = __any(flg[lane & 7] != 0u);
        if (!any_alive) break;
        __syncthreads();
    }
    __syncthreads();
    const int lane_e = lane_now(); const int hi_e = lane_e >> 5, tq_e = t0 + (lane_e & 31);
    bf16* yr = Y + (rowbase + tq_e) * D + h * 64; u32x2 wprev = {0u, 0u};
#pragma unroll
    for (int db = 0; db < 2; ++db)
#pragma unroll
        for (int g4 = 0; g4 < 4; ++g4) {
            const int e = 32 * db + 8 * g4 + 4 * hi_e;
            const u32x2 gw = gwv[db][g4];
            const float y0 = o[db][4 * g4 + 0] * silu_f(bf_lo(gw.x)), y1 = o[db][4 * g4 + 1] * silu_f(bf_hi(gw.x));
            const float y2 = o[db][4 * g4 + 2] * silu_f(bf_lo(gw.y)), y3 = o[db][4 * g4 + 3] * silu_f(bf_hi(gw.y));
            u32x2 w; w.x = cvtpk(y0, y1); w.y = cvtpk(y2, y3);
            if ((g4 & 1) == 0) wprev = w; else store_pair16(yr + 32 * db + 16 * (g4 >> 1) + 8 * hi_e, wprev, w);
        }
}

#define XB_TMO      128
#define XB_XCNT(j)  (256  + 64 * (j))
#define XB_XSUB(j)  (1280 + 64 * (j))
#define XB_XGEN(j)  (2304 + 64 * (j))
#define XB_TOP      3328
#define XB_TOPGEN   3392
#define XCD_BAR_WORDS 3456
#define XB_SPIN_CAP (1u << 18)

__device__ __forceinline__ unsigned xb_ld(unsigned* p)              { return __hip_atomic_load(p, __ATOMIC_RELAXED, __HIP_MEMORY_SCOPE_AGENT); }
__device__ __forceinline__ unsigned xb_add(unsigned* p, unsigned v) { return __hip_atomic_fetch_add(p, v, __ATOMIC_RELAXED, __HIP_MEMORY_SCOPE_AGENT); }
__device__ __forceinline__ unsigned xb_xcc_id() { return (unsigned)__builtin_amdgcn_s_getreg((3 << 11) | 20) & 0xFu; }
#define XB_SPIN(cond, bar) do { unsigned _sp = 0; while (cond) { __builtin_amdgcn_s_sleep(1); \
    if ((++_sp & 255u) == 0u) { if (xb_ld(&(bar)[XB_TMO])) break; if (_sp > XB_SPIN_CAP) { atomicAdd(&(bar)[XB_TMO], 1u); break; } } } } while (0)

struct XcdBarrier {
    unsigned* bar; unsigned x;
    volatile LAS unsigned* st;
};

__device__ __forceinline__ XcdBarrier xcd_barrier_post(unsigned* bar, volatile LAS unsigned* st, bool t0) {
    XcdBarrier b; b.bar = bar; b.x = xb_xcc_id(); b.st = st;
    if (t0) (void)xb_add(&bar[XB_XCNT(b.x)], 1u);
    return b;
}
__device__ __forceinline__ void xcd_barrier_complete(unsigned* bar, unsigned x, unsigned& nloc, unsigned& nx) {
    const unsigned G = gridDim.x * gridDim.y * gridDim.z;
    unsigned sum, cnt, mine, sp = 0u;
    for (;;) {
        sum = 0u; cnt = 0u; mine = 0u;
#pragma unroll
        for (unsigned j = 0; j < 16; ++j) { const unsigned c = xb_ld(&bar[XB_XCNT(j)]); sum += c; cnt += (c > 0u) ? 1u : 0u; mine = (j == x) ? c : mine; }
        if (sum == G) break;
        __builtin_amdgcn_s_sleep(1);
        if ((++sp & 255u) == 0u) { if (xb_ld(&bar[XB_TMO])) break; if (sp > XB_SPIN_CAP) { atomicAdd(&bar[XB_TMO], 1u); break; } }
    }
    nloc = mine > 0u ? mine : 1u; nx = cnt > 0u ? cnt : 1u;
}

__device__ __forceinline__ void xcd_barrier(const XcdBarrier& b, bool t0) {
    asm volatile("s_waitcnt vmcnt(0)" ::: "memory");
    __syncthreads();
    if (t0) {
        unsigned* bar = b.bar;
        __builtin_amdgcn_s_waitcnt(0);
        unsigned nloc = b.st[0], nx = b.st[1];
        if (nloc == 0u) { xcd_barrier_complete(bar, b.x, nloc, nx); b.st[0] = nloc; b.st[1] = nx; }
        const unsigned old = xb_add(&bar[XB_XSUB(b.x)], 1u);
        const unsigned gen = old / nloc;
        if (old + 1u == (gen + 1u) * nloc) {
            __builtin_amdgcn_fence(__ATOMIC_RELEASE, "agent");
            asm volatile("s_waitcnt vmcnt(0)" ::: "memory");
            const unsigned og = xb_add(&bar[XB_TOP], 1u);
            const unsigned tg = og / nx;
            if (og + 1u == (tg + 1u) * nx) xb_add(&bar[XB_TOPGEN], 1u);
            else XB_SPIN(xb_ld(&bar[XB_TOPGEN]) == tg, bar);
            __builtin_amdgcn_fence(__ATOMIC_ACQUIRE, "agent");
            xb_add(&bar[XB_XGEN(b.x)], 1u);
            asm volatile("s_waitcnt vmcnt(0)" ::: "memory");
        } else {
            XB_SPIN(xb_ld(&bar[XB_XGEN(b.x)]) == gen, bar);
            __builtin_amdgcn_fence(__ATOMIC_ACQUIRE, "agent");
            asm volatile("s_waitcnt vmcnt(0)" ::: "memory");
        }
    }
    __syncthreads();
}

#ifndef MK_SINGLE
#define MK_SINGLE 1
#endif
constexpr int NPHASE = 11;
struct Args { const float* in[23]; float* out; unsigned char* ws; int ph_lo, ph_hi; };

__global__ void __launch_bounds__(NWAVES * 64, 2) hybrid_fwd(Args args) {
    extern __shared__ __attribute__((aligned(16))) unsigned char lds[];
    const int wid = __builtin_amdgcn_readfirstlane((int)threadIdx.x >> 6);
    const int G = gridDim.x; const int bx = blockIdx.x;
    const int vcu = (G % 8 == 0) ? (bx % 8) * (G / 8) + bx / 8 : bx;
    const int gw = vcu * NWAVES + wid, NGW = G * NWAVES;
#define LANE_TID() const int lane = lane_now(); const int tid = wid * 64 + lane; (void)tid
    unsigned char* ws = args.ws;
    const float* x = args.in[0]; const float* cvec = args.in[1]; const int* pos = (const int*)args.in[2];
    float* mod_e = (float*)(ws + WS_MOD); float* mod_o = mod_e + 4 * 3072;
    bf16* WinE = (bf16*)(ws + WS_WINE); bf16* WoutE = (bf16*)(ws + WS_WOUTE); bf16* WinO = (bf16*)(ws + WS_WINO); bf16* WoutO = (bf16*)(ws + WS_WOUTO);
    bf16* H = (bf16*)(ws + WS_H); bf16* Y = H; bf16* VT = (bf16*)(ws + WS_VT); bf16* U = (bf16*)(ws + WS_U);
    bf16* VTa = VT; bf16* VTb = VT + (size_t)512 * M;
    float* scrf = (float*)(lds + LDS_SCR + wid * 8448);
    const int lo = args.ph_lo, hi_ph = args.ph_hi;
#define IN(k) (lo <= (k) && (k) < hi_ph)
#define SEAM(k) do { if (IN(k) && IN((k) + 1)) { xcd_barrier(bar, wid == 0 && lane_now() == 0); } } while (0)
    if (args.ph_lo < 0) cg::this_grid().sync();
    volatile LAS unsigned* MISC = (volatile LAS unsigned*)((LAS unsigned char*)lds + LDS_MISC);
    if (wid == 0) MISC[lane_now()] = 0u;
    __syncthreads();
    XcdBarrier bar = xcd_barrier_post((unsigned*)(ws + WS_BAR), MISC + 8, wid == 0 && lane_now() == 0);

    if (IN(0)) {
        LANE_TID();
        if (bx < 192) p0_silu_to_lds(cvec, (float*)lds + 1024, tid);
        for (int it = bx; it < 192; it += G) {
            const int l = it / 96, j0 = (it % 96) * 32;
            p0_mod_item((const float*)lds + 1024, l ? args.in[19] : args.in[4], (l ? args.in[20] : args.in[5]), l ? mod_o : mod_e, j0, (float*)lds, wid, lane, tid);
        }
        constexpr int I_INE = 16 * (EIN / 32), I_OUT = 16 * (D / 32), I_INO = 16 * (OIN / 32);
        constexpr int NITEMS = I_INE + I_OUT + I_INO + I_OUT;
        for (int it = gw; it < NITEMS; it += NGW) {
            int r = it;
            if (r < I_INE) { p0_transpose_item(args.in[6], D, EIN, WinE, scrf, r, lane, 0, 1.f, 2); continue; } r -= I_INE;
            if (r < I_OUT) { p0_transpose_item(args.in[17], D, D, WoutE, scrf, r, lane, 0, 1.f, 0); continue; } r -= I_OUT;
            if (r < I_INO) { p0_transpose_item(args.in[21], D, OIN, WinO, scrf, r, lane, 1024, QS, 1); continue; } r -= I_INO;
            p0_transpose_item(args.in[22], D, D, WoutO, scrf, r, lane, 0, 1.f, 0);
        }
    }
    SEAM(0);
    if (IN(1)) { LANE_TID(); p_hrows(x, H, args.in[3], mod_e, gw, NGW, lane); }
    SEAM(1);
    if (IN(2)) {
        { pg8::Gemm g{H, WinE, M, EU, D}; pg8::StaticOrder So; So.init(M, EU, G, bx);
          pg8::EpiStore E{U, EU};
          pg8::gemm_phase<pg8::EpiStore, pg8::StaticOrder, true, true>((PG8_LAS unsigned char*)lds, g, So, E, wid); }
        { pg8::Gemm g{WinE + (size_t)EU * D, H, 512, M, D}; pg8::StaticOrder So; So.init(512, M, G, bx);
          pg8::EpiStore E{VTa, M};
          pg8::gemm_phase<pg8::EpiStore, pg8::StaticOrder, true, true>((PG8_LAS unsigned char*)lds, g, So, E, wid); }
    }
    SEAM(2);
    if (IN(3)) {
        LANE_TID();
        p_normrope(U, pos, args.in[7], args.in[8], args.in[14], args.in[15], scrf, gw, NGW, lane);
        for (int it = gw; it < 4 * 128 * 2; it += NGW) {
            const int ct = it & 1, st = (it >> 1) & 127, b = it >> 8;
            p_vt_item(U, EU, C_VB + 64 * ct, VTb, 128, 64 * ct, b, 64 * st, (unsigned*)scrf, lane);
        }
    }
    SEAM(3);
    if (IN(4)) {
        const int lane4 = lane_now(); const int tid4 = wid * 64 + lane4;
        float lam;
        { const float p1 = args.in[9][lane4] * args.in[10][lane4], p2 = args.in[11][lane4] * args.in[12][lane4];
          lam = expf(wave_sum(p1)) - expf(wave_sum(p2)) + 0.2f; }
        bool fixm;
        { float gq = fabsf(args.in[7][lane4]), gk = fabsf(args.in[8][lane4]);
#pragma unroll
          for (int o2 = 1; o2 < 64; o2 <<= 1) { gq = fmaxf(gq, __shfl_xor(gq, o2)); gk = fmaxf(gk, __shfl_xor(gk, o2)); }
          fixm = (8.f * gq * gk * LOG2E <= 100.f); }
#ifndef NO_DIFF
        for (int p = vcu; p < 256; p += G) {
            const int bh = p >> 4, s = p & 15;
#pragma unroll 1
            for (int hf = 0; hf < 2; ++hf) {
                if (fixm) diff_unit<true>(bh >> 2, bh & 3, hf ? 31 - s : s, lam, U, VTa, Y, args.in[13], args.in[7], pos, lds, tid4, wid, lane4);
                else diff_unit<false>(bh >> 2, bh & 3, hf ? 31 - s : s, lam, U, VTa, Y, args.in[13], args.in[7], pos, lds, tid4, wid, lane4);
            }
        }
#endif
        const int lane4b = lane_now();
#ifndef NO_SWA
        for (int u = vcu; u < 256; u += G) swa_unit(u >> 6, (u >> 5) & 1, u & 31, U, VTb, Y, args.in[16], args.in[14], pos, lds, wid, lane4b);
#endif
    }
    SEAM(4);
    if (IN(5)) {
        pg8::Gemm g{Y, WoutE, M, D, D}; pg8::StaticOrder So; So.init(M, D, G, bx);
        pg8::EpiResid E{x, args.out, mod_e + 2048};
        pg8::gemm_phase<pg8::EpiResid, pg8::StaticOrder, true, true>((PG8_LAS unsigned char*)lds, g, So, E, wid);
    }
    SEAM(5);
    if (IN(6)) { LANE_TID(); p_hrows(args.out, H, args.in[18], mod_o, gw, NGW, lane); }
    SEAM(6);
    if (IN(7)) {
        { pg8::Gemm g{H, WinO, M, U1LD, D}; pg8::StaticOrder So; So.init(M, U1LD, G, bx);
          pg8::EpiStore E{U, U1LD};
          pg8::gemm_phase<pg8::EpiStore, pg8::StaticOrder, true, true>((PG8_LAS unsigned char*)lds, g, So, E, wid); }
        { pg8::Gemm g{WinO + (size_t)U1LD * D, H, 1024, M, D}; pg8::StaticOrder So; So.init(1024, M, G, bx);
          pg8::EpiStore E{VT, M};
          pg8::gemm_phase<pg8::EpiStore, pg8::StaticOrder, true, true>((PG8_LAS unsigned char*)lds, g, So, E, wid); }
    }
    SEAM(7);
    if (IN(9)) {
        const int lane9 = lane_now(); const int tid9 = wid * 64 + lane9;
        for (int run = vcu; run < 256; run += G) {
            const int bh = run >> 2; int res_lo = 1 << 30, res_hi = -1;
#pragma unroll 1
            for (int i = 7; i >= 0; --i) sb_unit(bh >> 4, bh & 15, (run & 3) * 8 + i, U, VT, Y, lds, wid, lane9, res_lo, res_hi);
        }
    }
    SEAM(9);
    if (IN(10)) {
        pg8::Gemm g{Y, WoutO, M, D, D}; pg8::StaticOrder So; So.init(M, D, G, bx);
        pg8::EpiResid E{args.out, args.out, mod_o + 2048};
        pg8::gemm_phase<pg8::EpiResid, pg8::StaticOrder, true, true>((PG8_LAS unsigned char*)lds, g, So, E, wid);
    }
#undef IN
#undef SEAM
}

extern "C" void kernel_launch(void* const* d_in, const int* in_sizes, int n_in, void* d_out, int out_size, void* d_ws, size_t ws_size, hipStream_t stream) {
    static int grid = 0;
    if (grid == 0) {
        if (n_in != 23 || out_size != M * D || ws_size < WS_END) { fprintf(stderr, "kernel_launch: unexpected shapes (n_in %d out %d ws %zu)\n", n_in, out_size, ws_size); grid = -1; return; }
        int dev = 0, cus = 0, per_cu = 0;
        hipGetDevice(&dev); hipDeviceGetAttribute(&cus, hipDeviceAttributeMultiprocessorCount, dev);
        if (hipFuncSetAttribute((const void*)hybrid_fwd, hipFuncAttributeMaxDynamicSharedMemorySize, LDS_BYTES) != hipSuccess) { fprintf(stderr, "kernel_launch: hipFuncSetAttribute failed\n"); grid = -1; return; }
        hipOccupancyMaxActiveBlocksPerMultiprocessor(&per_cu, (const void*)hybrid_fwd, NWAVES * 64, LDS_BYTES);
        (void)hipGetLastError();
        if (per_cu < 1) per_cu = 1;
        grid = cus * 1;
        if (grid <= 0) grid = 256;
    }
    if (grid < 0) return;
    if (hipMemsetAsync((char*)d_ws + WS_BAR, 0, XCD_BAR_WORDS * 4, stream) != hipSuccess) { fprintf(stderr, "kernel_launch: memset failed\n"); return; }
    Args a{};
    for (int i = 0; i < 23; ++i) a.in[i] = (const float*)d_in[i];
    a.out = (float*)d_out; a.ws = (unsigned char*)d_ws;
#if MK_SINGLE
    a.ph_lo = 0; a.ph_hi = NPHASE;
    void* kargs[] = {&a};
    hipError_t e = hipLaunchCooperativeKernel((const void*)hybrid_fwd, dim3(grid), dim3(NWAVES * 64), kargs, LDS_BYTES, stream);
    if (e != hipSuccess) fprintf(stderr, "cooperative launch failed: %s (grid %d)\n", hipGetErrorString(e), grid);
#else
    for (int ph = 0; ph < NPHASE; ++ph) {
        a.ph_lo = ph; a.ph_hi = ph + 1;
        hipLaunchKernelGGL(hybrid_fwd, dim3(grid), dim3(NWAVES * 64), LDS_BYTES, stream, a);
    }
#endif
}
```

```cpp
#include <hip/hip_runtime.h>
#include <hip/hip_cooperative_groups.h>
#include <cstdio>
#include <cstdint>
namespace cg = cooperative_groups;
namespace pg8 {
#define PG8_LAS __attribute__((address_space(3)))
typedef unsigned short bf16_t;
typedef short bf16x8 __attribute__((ext_vector_type(8)));
typedef float f32x4 __attribute__((ext_vector_type(4)));
typedef unsigned u32x4 __attribute__((ext_vector_type(4)));
constexpr int BM = 256, BK = 64, HALF = 128, HTB = HALF * BK * 2  , STAGE_BYTES = 8 * HTB, NXCD = 8, WGM = 8;

__host__ __device__ __forceinline__ int lds_byte(int r, int c) { const int st = (r >> 4) * 2 + (c >> 5), rr = r & 15, cc = c & 31, ob = rr * 64 + cc * 2; return st * 1024 + (ob ^ (((ob >> 9) & 1) << 5)); }
__host__ __device__ __forceinline__ void stage_rc(int b, int& R, int& C) { const int st = b / 1024, sb = b % 1024, swz = sb ^ (((sb >> 9) & 1) << 5); R = (st >> 1) * 16 + swz / 64; C = (st & 1) * 32 + (swz % 64) / 2; }
__host__ __device__ __forceinline__ int perm32(int rho) { const int n = rho >> 4, i = rho & 15; return 8 * (i >> 2) + 4 * n + (i & 3); }

struct Unit { int pm, pn; };
struct Gemm { const bf16_t* A; const bf16_t* Bt; int M, N, K; };

struct StaticOrder {
    int nM, nN, nwg, G, c;
    __host__ __device__ void init(int M, int N, int G_, int c_) { nM = M / BM; nN = N / BM; nwg = nM * nN; G = G_; c = c_; }
    __host__ __device__ bool next(int i, Unit& u) const {
        const long L = (long)i * G + c; if (L >= nwg) return false;
        int wgid = (int)L; { const int q = nwg / NXCD, r = nwg % NXCD, xcd = wgid % NXCD, off = wgid / NXCD; wgid = (xcd < r ? xcd * (q + 1) : r * (q + 1) + (xcd - r) * q) + off; }
        const int nig = WGM * nN, gid = wgid / nig, fm = gid * WGM, gsz = (nM - fm) < WGM ? (nM - fm) : WGM;
        u.pm = fm + ((wgid % nig) % gsz); u.pn = (wgid % nig) / gsz; return true;
    }
    __device__ __forceinline__ void a_ready(const Unit&) const {}
    __device__ __forceinline__ void done(const Unit&) const {}
};

__device__ __forceinline__ unsigned cvt_pk_bf16(float lo, float hi) { unsigned r; asm volatile("v_cvt_pk_bf16_f32 %0, %1, %2" : "=v"(r) : "v"(lo), "v"(hi)); return r; }
typedef float f32x2 __attribute__((ext_vector_type(2)));
template <class Epi, class Sched, bool ALIGN_EPI = false, bool SP2 = false>
__device__ __forceinline__ void gemm_phase(PG8_LAS unsigned char* lds, const Gemm g, const Sched& S, const Epi& E, const int wid) {
    int lane; asm volatile("v_mbcnt_lo_u32_b32 %0, -1, 0\n\tv_mbcnt_hi_u32_b32 %0, -1, %0" : "=v"(lane));
    const int tid = wid * 64 + lane, wr = wid >> 2, wc = wid & 3, fr = lane & 15, fq = lane >> 4;
    const int K = g.K, nt = K / BK;
    unsigned voffA[2], voffB[2];
#pragma unroll
    for (int i = 0; i < 2; ++i) { int R, C; stage_rc(tid * 16 + i * 8192, R, C); const int Rb = Epi::PERM ? ((R & ~31) + perm32(R & 31)) : R;
        voffA[i] = (unsigned)(R * K + C) * 2u; voffB[i] = (unsigned)(Rb * K + C) * 2u; }
    const size_t kstep = (size_t)(BK * 2);
    const size_t hstep = (size_t)HALF * K * 2;
    const size_t tstep = 2 * hstep;
    const unsigned ldsw = (unsigned)wid * 1024u;
    const int aoff = lds_byte(wr * 64 + fr, fq * 8), boff = lds_byte(wc * 32 + fr, fq * 8);
#define PG8_SA(b, h) (((b) * 2 + (h)) * HTB)
#define PG8_SB(b, h) ((4 + (b) * 2 + (h)) * HTB)
#define PG8_STAGE(bufoff, gbase, voff) do { _Pragma("unroll") for (int _i = 0; _i < 2; ++_i) \
        __builtin_amdgcn_global_load_lds((const unsigned*)((const char*)(gbase) + (voff)[_i]), (PG8_LAS unsigned*)(lds + (bufoff) + ldsw + _i * 8192), 16, 0, 0); } while (0)
#define PG8_LDA(dst, b, h) do { _Pragma("unroll") for (int m = 0; m < 4; ++m) _Pragma("unroll") for (int k = 0; k < 2; ++k) dst[m][k] = *(const PG8_LAS bf16x8*)(lds + PG8_SA(b, h) + aoff + m * 2048 + k * 1024); } while (0)
#define PG8_LDB(dst, b, h) do { _Pragma("unroll") for (int n = 0; n < 2; ++n) _Pragma("unroll") for (int k = 0; k < 2; ++k) dst[n][k] = *(const PG8_LAS bf16x8*)(lds + PG8_SB(b, h) + boff + n * 2048 + k * 1024); } while (0)
#define PG8_MMA(ai, bj, At, Bt) do { __builtin_amdgcn_s_setprio(1); _Pragma("unroll") for (int m = 0; m < 4; ++m) _Pragma("unroll") for (int n = 0; n < 2; ++n) _Pragma("unroll") for (int k = 0; k < 2; ++k) \
        acc[ai][bj][m][n] = __builtin_amdgcn_mfma_f32_16x16x32_bf16(Bt[n][k], At[m][k], acc[ai][bj][m][n], 0, 0, 0); __builtin_amdgcn_s_setprio(0); } while (0)
#define PG8_WAIT_V(n) asm volatile("s_waitcnt vmcnt(" #n ")" ::: "memory")
#define PG8_WAIT_L(n) asm volatile("s_waitcnt lgkmcnt(" #n ")" ::: "memory")
#define PG8_BAR __builtin_amdgcn_s_barrier()
#define PG8_SCHED __builtin_amdgcn_sched_barrier(0)
    Unit cur, nxt; int ui = 0;
    if (!S.next(0, cur)) return;
    f32x4 acc[2][2][4][2];
#pragma unroll
    for (int a = 0; a < 2; ++a)
#pragma unroll
        for (int b = 0; b < 2; ++b)
#pragma unroll
            for (int m = 0; m < 4; ++m)
#pragma unroll
                for (int n = 0; n < 2; ++n) acc[a][b][m][n] = (f32x4){0.f, 0.f, 0.f, 0.f};
    bf16x8 At[4][2], B0[2][2], B1[2][2];
    const char* cA = (const char*)g.A + (size_t)cur.pm * tstep; const char* cB = (const char*)g.Bt + (size_t)cur.pn * tstep;
    S.a_ready(cur);
    if constexpr (SP2) {
        PG8_STAGE(PG8_SB(0, 0), cB, voffB); PG8_STAGE(PG8_SB(0, 1), cB + hstep, voffB); PG8_STAGE(PG8_SA(0, 0), cA, voffA); PG8_STAGE(PG8_SA(0, 1), cA + hstep, voffA);
        if (wr == 1) PG8_BAR;
        PG8_WAIT_V(2); PG8_BAR;
        PG8_STAGE(PG8_SB(1, 0), cB + kstep, voffB); PG8_STAGE(PG8_SA(1, 0), cA + kstep, voffA); PG8_STAGE(PG8_SB(1, 1), cB + hstep + kstep, voffB);
        PG8_WAIT_V(6); PG8_BAR;
    } else {
        PG8_STAGE(PG8_SB(0, 0), cB, voffB); PG8_STAGE(PG8_SA(0, 0), cA, voffA); PG8_STAGE(PG8_SB(0, 1), cB + hstep, voffB); PG8_STAGE(PG8_SA(0, 1), cA + hstep, voffA);
        if (wr == 1) PG8_BAR;
        PG8_WAIT_V(4); PG8_BAR;
        PG8_STAGE(PG8_SB(1, 0), cB + kstep, voffB); PG8_STAGE(PG8_SA(1, 0), cA + kstep, voffA); PG8_STAGE(PG8_SB(1, 1), cB + hstep + kstep, voffB);
        PG8_WAIT_V(6); PG8_BAR;
    }
    for (;;) {
        const bool has_next = S.next(ui + 1, nxt);
        const char* nA = has_next ? (const char*)g.A + (size_t)nxt.pm * tstep : cA; const char* nB = has_next ? (const char*)g.Bt + (size_t)nxt.pn * tstep : cB;
        for (int t = 0; t < nt; t += 2) {
            const bool last = (t == nt - 2);
            const char* a1 = cA + (size_t)(t + 1) * kstep;
            const char* a2 = last ? nA : cA + (size_t)(t + 2) * kstep; const char* b2 = last ? nB : cB + (size_t)(t + 2) * kstep;
            const char* a3 = a2 + kstep; const char* b3 = b2 + kstep;
            if (last && has_next) S.a_ready(nxt);
            if constexpr (SP2) {
            PG8_LDB(B0, 0, 0); PG8_LDB(B1, 0, 1); PG8_SCHED; PG8_LDA(At, 0, 0); PG8_STAGE(PG8_SA(1, 1), a1 + hstep, voffA);
            PG8_WAIT_V(8); PG8_WAIT_L(0); PG8_BAR; PG8_MMA(0, 0, At, B0); PG8_MMA(0, 1, At, B1); PG8_BAR; PG8_SCHED;
            PG8_LDA(At, 0, 1); PG8_STAGE(PG8_SB(0, 0), b2, voffB); PG8_STAGE(PG8_SB(0, 1), b2 + hstep, voffB); PG8_STAGE(PG8_SA(0, 0), a2, voffA);
            PG8_WAIT_V(8); PG8_WAIT_L(0); PG8_BAR; PG8_MMA(1, 0, At, B0); PG8_MMA(1, 1, At, B1); PG8_BAR; PG8_SCHED;
            PG8_LDB(B0, 1, 0); PG8_LDB(B1, 1, 1); PG8_SCHED; PG8_LDA(At, 1, 0); PG8_STAGE(PG8_SA(0, 1), a2 + hstep, voffA);
            PG8_WAIT_V(8); PG8_WAIT_L(0); PG8_BAR; PG8_MMA(0, 0, At, B0); PG8_MMA(0, 1, At, B1); PG8_BAR; PG8_SCHED;
            PG8_LDA(At, 1, 1); PG8_STAGE(PG8_SB(1, 0), b3, voffB); PG8_STAGE(PG8_SB(1, 1), b3 + hstep, voffB); PG8_STAGE(PG8_SA(1, 0), a3, voffA);
            PG8_WAIT_V(8); PG8_WAIT_L(0); PG8_BAR; PG8_MMA(1, 0, At, B0); PG8_MMA(1, 1, At, B1); PG8_BAR; PG8_SCHED;
            } else {
            PG8_LDB(B0, 0, 0); PG8_SCHED; PG8_LDA(At, 0, 0); PG8_STAGE(PG8_SA(1, 1), a1 + hstep, voffA);
            PG8_WAIT_L(8); PG8_BAR; PG8_WAIT_L(0); PG8_MMA(0, 0, At, B0); PG8_BAR; PG8_SCHED;
            PG8_LDB(B1, 0, 1); PG8_STAGE(PG8_SB(0, 0), b2, voffB);
            PG8_BAR; PG8_WAIT_L(0); PG8_MMA(0, 1, At, B1); PG8_BAR;
            PG8_LDA(At, 0, 1); PG8_STAGE(PG8_SA(0, 0), a2, voffA);
            PG8_BAR; PG8_WAIT_L(0); PG8_MMA(1, 0, At, B0); PG8_BAR; PG8_SCHED;
            PG8_STAGE(PG8_SB(0, 1), b2 + hstep, voffB);
            PG8_WAIT_V(6); PG8_BAR; PG8_MMA(1, 1, At, B1); PG8_BAR;
            PG8_LDB(B0, 1, 0); PG8_SCHED; PG8_LDA(At, 1, 0); PG8_STAGE(PG8_SA(0, 1), a2 + hstep, voffA);
            PG8_WAIT_L(8); PG8_BAR; PG8_WAIT_L(0); PG8_MMA(0, 0, At, B0); PG8_BAR; PG8_SCHED;
            PG8_LDB(B1, 1, 1); PG8_STAGE(PG8_SB(1, 0), b3, voffB);
            PG8_BAR; PG8_WAIT_L(0); PG8_MMA(0, 1, At, B1); PG8_BAR;
            PG8_LDA(At, 1, 1); PG8_STAGE(PG8_SA(1, 0), a3, voffA);
            PG8_BAR; PG8_WAIT_L(0); PG8_MMA(1, 0, At, B0); PG8_BAR; PG8_SCHED;
            PG8_STAGE(PG8_SB(1, 1), b3 + hstep, voffB);
            PG8_WAIT_V(6); PG8_BAR; PG8_MMA(1, 1, At, B1); PG8_BAR;
            }
        }
        if constexpr (ALIGN_EPI) { if (wr == 0) PG8_BAR; }
        if constexpr (!Epi::AFTER_DRAIN) { E(acc, cur, wr, wc, fr, fq); S.done(cur); }
        if (!has_next) break;
#pragma unroll
        for (int a = 0; a < 2; ++a)
#pragma unroll
            for (int b = 0; b < 2; ++b)
#pragma unroll
                for (int m = 0; m < 4; ++m)
#pragma unroll
                    for (int n = 0; n < 2; ++n) acc[a][b][m][n] = (f32x4){0.f, 0.f, 0.f, 0.f};
        cur = nxt; cA = nA; cB = nB; ++ui;
        if constexpr (ALIGN_EPI) { if (wr == 1) PG8_BAR; }
    }
    PG8_WAIT_V(0);
    if constexpr (!ALIGN_EPI) { if (wr == 0) PG8_BAR; }
    PG8_BAR;
    if constexpr (Epi::AFTER_DRAIN) { E.fused(acc, cur, wr, wc, fr, fq, lds, wid, lane); S.done(cur); }
#undef PG8_SA
#undef PG8_SB
#undef PG8_STAGE
#undef PG8_LDA
#undef PG8_LDB
#undef PG8_MMA
#undef PG8_WAIT_V
#undef PG8_WAIT_L
#undef PG8_BAR
#undef PG8_SCHED
}
}

namespace pg8 {
struct EpiStore {
    static constexpr bool PERM = true, AFTER_DRAIN = false;
    bf16_t* O; int ldc;
    __device__ __forceinline__ void operator()(const f32x4 (&acc)[2][2][4][2], const Unit& u, int wr, int wc, int fr, int fq) const {
        const int row0 = u.pm * BM + wr * 64 + fr; const int col0 = u.pn * BM + wc * 32 + 8 * fq;
#pragma unroll
        for (int ai = 0; ai < 2; ++ai)
#pragma unroll
            for (int m = 0; m < 4; ++m) { bf16_t* rowp = O + (size_t)(row0 + ai * HALF + m * 16) * ldc + col0;
#pragma unroll
                for (int bj = 0; bj < 2; ++bj) { const f32x4 v0 = acc[ai][bj][m][0], v1 = acc[ai][bj][m][1];
                    u32x4 w; w.x = cvt_pk_bf16(v0[0], v0[1]); w.y = cvt_pk_bf16(v0[2], v0[3]); w.z = cvt_pk_bf16(v1[0], v1[1]); w.w = cvt_pk_bf16(v1[2], v1[3]);
                    *(u32x4*)(rowp + bj * HALF) = w; } }
    }
};
struct EpiResid {
    static constexpr bool PERM = false, AFTER_DRAIN = false;
    const float* base; float* out; const float* gate;
    __device__ __forceinline__ void operator()(const f32x4 (&acc)[2][2][4][2], const Unit& u, int wr, int wc, int fr, int fq) const {
        const int hi8 = fr >> 3;
        const int rowA = u.pm * BM + wr * 64 + (fr & 7), rowB = rowA + 8; const int col0 = u.pn * BM + wc * 32 + 16 * hi8 + 4 * fq;
        const float* gb = gate + (size_t)((u.pm * BM) / 8192) * 3072 + col0;
        f32x4 gs[2];
#pragma unroll
        for (int bj = 0; bj < 2; ++bj) gs[bj] = *(const f32x4*)(gb + bj * HALF);
#pragma unroll
        for (int ai = 0; ai < 2; ++ai)
#pragma unroll
            for (int m = 0; m < 4; ++m) { const size_t offA = (size_t)(rowA + ai * HALF + m * 16) * 1024 + col0, offB = (size_t)(rowB + ai * HALF + m * 16) * 1024 + col0;
#pragma unroll
                for (int bj = 0; bj < 2; ++bj) {
                    const f32x4 x0 = acc[ai][bj][m][0], x1 = acc[ai][bj][m][1]; f32x4 za, zb;
#pragma unroll
                    for (int e = 0; e < 4; ++e) {
                        const float s1 = __shfl_xor(x1[e], 8), s0 = __shfl_xor(x0[e], 8);
                        za[e] = hi8 ? s1 : x0[e];
                        zb[e] = hi8 ? x1[e] : s0; }
                    const f32x4 ba = *(const f32x4*)(base + offA + bj * HALF), bb = *(const f32x4*)(base + offB + bj * HALF);
                    *(f32x4*)(out + offA + bj * HALF) = ba + gs[bj] * za;
                    *(f32x4*)(out + offB + bj * HALF) = bb + gs[bj] * zb; } }
    }
};
}

typedef unsigned short bf16;
typedef short bf16x8 __attribute__((ext_vector_type(8)));
typedef float f32x4 __attribute__((ext_vector_type(4)));
typedef float f32x16 __attribute__((ext_vector_type(16)));
typedef unsigned u32x4 __attribute__((ext_vector_type(4)));
typedef unsigned u32x2 __attribute__((ext_vector_type(2)));
typedef float f32x2_t __attribute__((ext_vector_type(2)));
typedef __bf16 bf16x2_t __attribute__((ext_vector_type(2)));
#define LAS __attribute__((address_space(3)))

constexpr int NB = 4, S = 8192, D = 1024, M = NB * S;
constexpr int EIN = 3328, OIN = 4096, U1LD = 3072, EU = 2816;
constexpr int C_QA = 0, C_KA = 512, C_GA = 1024, C_QB = 1536, C_KB = 2048, C_VB = 2176, C_GB = 2304;
constexpr float LOG2E = 1.4426950408889634f;
constexpr float QS = 0.125f * LOG2E;
constexpr float EPS = 1e-6f;
constexpr int NWAVES = 8;

constexpr size_t MiB = 1u << 20;
constexpr size_t WS_BAR = 0;
constexpr size_t WS_MOD = 1 * MiB;
constexpr size_t WS_WINE = 2 * MiB, WS_WOUTE = 9 * MiB, WS_WINO = 11 * MiB, WS_WOUTO = 19 * MiB;
constexpr size_t WS_H = 32 * MiB;
constexpr size_t WS_VT = 96 * MiB;
constexpr size_t WS_U = 160 * MiB;
constexpr size_t WS_END = 416 * MiB;
constexpr int LDS_BYTES = 147456;
constexpr int LDS_SCR = 65536;
constexpr int LDS_MISC = 135168;

__device__ __forceinline__ unsigned cvtpk(float lo, float hi) { f32x2_t v = {lo, hi}; bf16x2_t b = __builtin_convertvector(v, bf16x2_t); return __builtin_bit_cast(unsigned, b); }
__device__ __forceinline__ float bf_lo(unsigned w) { return __uint_as_float(w << 16); }
__device__ __forceinline__ float bf_hi(unsigned w) { return __uint_as_float(w & 0xffff0000u); }
__device__ __forceinline__ float wave_sum(float v) {
#pragma unroll
    for (int o = 1; o < 64; o <<= 1) v += __shfl_xor(v, o);
    return v;
}
__device__ __forceinline__ float half_max(float m) { auto rr = __builtin_amdgcn_permlane32_swap(__float_as_uint(m), __float_as_uint(m), false, false); return fmaxf(__uint_as_float(rr[0]), __uint_as_float(rr[1])); }
__device__ __forceinline__ float half_sum(float m) { auto rr = __builtin_amdgcn_permlane32_swap(__float_as_uint(m), __float_as_uint(m), false, false); return __uint_as_float(rr[0]) + __uint_as_float(rr[1]); }
__device__ __forceinline__ int pi32(int i) { return (i & 0x13) | ((i & 8) >> 1) | ((i & 4) << 1); }
__device__ __forceinline__ float silu_f(float x) { return x * __builtin_amdgcn_rcpf(1.f + __expf(-x)); }
__device__ __forceinline__ int lane_now() { int l; asm volatile("v_mbcnt_lo_u32_b32 %0, -1, 0\n\tv_mbcnt_hi_u32_b32 %0, -1, %0" : "=v"(l)); return l; }
__device__ __forceinline__ void store_pair16(bf16* rowp16, u32x2 wk, u32x2 wk1) {
    auto r0 = __builtin_amdgcn_permlane32_swap(wk.x, wk1.x, false, false);
    auto r1 = __builtin_amdgcn_permlane32_swap(wk.y, wk1.y, false, false);
    u32x4 v; v.x = r0[0]; v.y = r1[0]; v.z = r0[1]; v.w = r1[1];
    *(u32x4*)rowp16 = v;
}
#define MFMA32(a, b, c) __builtin_amdgcn_mfma_f32_32x32x16_bf16((a), (b), (c), 0, 0, 0)

__device__ __forceinline__ void p0_silu_to_lds(const float* c, float* sc, int tid) {
#pragma unroll
    for (int i = 0; i < 8; ++i) { const float cb = c[tid + 512 * i]; sc[tid + 512 * i] = cb / (1.f + expf(-cb)); }
    __syncthreads();
}
__device__ __forceinline__ void p0_mod_item(const float* sc, const float* Wm, const float* bm, float* mod, int j0, float* red, int wid, int lane, int tid) {
    const int cl = lane & 31, kh = lane >> 5;
    float acc[4] = {0.f, 0.f, 0.f, 0.f};
#pragma unroll 16
    for (int i = 0; i < 64; ++i) {
        const int k = wid * 128 + 2 * i + kh; const float wv = Wm[(size_t)k * 3072 + j0 + cl];
#pragma unroll
        for (int b = 0; b < 4; ++b) acc[b] += sc[b * 1024 + k] * wv;
    }
#pragma unroll
    for (int b = 0; b < 4; ++b) acc[b] += __shfl_xor(acc[b], 32);
    if (lane < 32) {
#pragma unroll
        for (int b = 0; b < 4; ++b) red[(wid * 4 + b) * 32 + cl] = acc[b];
    }
    __syncthreads();
    if (tid < 128) { const int b = tid >> 5, c2 = tid & 31; float s = bm[j0 + c2];
#pragma unroll
        for (int w = 0; w < 8; ++w) s += red[(w * 4 + b) * 32 + c2];
        mod[b * 3072 + j0 + c2] = s; }
    __syncthreads();
}
__device__ __forceinline__ void p0_transpose_item(const float* W, int K, int N, bf16* WT, float* scr, int item, int lane, int nscale, float sc, int perm) {
    const int nblk = N / 32, kb = item / nblk, nb = item % nblk, k0 = 64 * kb, n0 = 32 * nb;
    int nd0 = n0;
    if (perm == 1) nd0 = (n0 < 2048 ? n0 : (n0 < 3072 ? n0 + 1024 : n0 - 1024));
    if (perm == 2) nd0 = (n0 < 1024 ? n0 : (n0 < 1536 ? n0 + 1792 : (n0 < 2688 ? n0 - 512 : n0 - 512)));
    const float f = (n0 < nscale) ? sc : 1.f;
#pragma unroll 8
    for (int i = 0; i < 32; ++i) { const int kk = 2 * i + (lane >> 5); scr[kk * 33 + (lane & 31)] = W[(size_t)(k0 + kk) * N + n0 + (lane & 31)] * f; }
    __builtin_amdgcn_wave_barrier();
    const int c = lane & 7;
#pragma unroll
    for (int j = 0; j < 4; ++j) { const int n = (lane >> 3) + 8 * j; const float* s = scr + (8 * c) * 33 + n;
        u32x4 o; o.x = cvtpk(s[0 * 33], s[1 * 33]); o.y = cvtpk(s[2 * 33], s[3 * 33]); o.z = cvtpk(s[4 * 33], s[5 * 33]); o.w = cvtpk(s[6 * 33], s[7 * 33]);
        *(u32x4*)(WT + (size_t)(nd0 + n) * K + k0 + 8 * c) = o; }
    __builtin_amdgcn_wave_barrier();
}

__device__ __forceinline__ void p_hrows(const float* X, bf16* H, const float* ng, const float* mod, int gw, int NGW, int lane) {
    for (int ch = gw; ch < M / 16; ch += NGW) {
        const int m0 = ch * 16, b = m0 / S; const float* mb = mod + b * 3072;
        f32x4 A[4], SH[4];
#pragma unroll
        for (int j = 0; j < 4; ++j) { const int col = 4 * lane + 256 * j; const f32x4 g = *(const f32x4*)(ng + col); const f32x4 sc = *(const f32x4*)(mb + 1024 + col); A[j] = g * (1.f + sc); SH[j] = *(const f32x4*)(mb + col); }
#pragma unroll 1
        for (int r0 = 0; r0 < 16; r0 += 4) {
            f32x4 v[4][4];
#pragma unroll
            for (int rr = 0; rr < 4; ++rr) { const float* xr = X + (size_t)(m0 + r0 + rr) * D;
#pragma unroll
                for (int j = 0; j < 4; ++j) v[rr][j] = *(const f32x4*)(xr + 4 * lane + 256 * j); }
#pragma unroll
            for (int rr = 0; rr < 4; ++rr) {
                float ss = 0.f;
#pragma unroll
                for (int j = 0; j < 4; ++j) ss += (v[rr][j].x * v[rr][j].x + v[rr][j].y * v[rr][j].y) + (v[rr][j].z * v[rr][j].z + v[rr][j].w * v[rr][j].w);
                ss = wave_sum(ss); const float rstd = 1.0f / sqrtf(ss * (1.f / D) + EPS);
                bf16* hr = H + (size_t)(m0 + r0 + rr) * D;
#pragma unroll
                for (int j = 0; j < 4; ++j) { const f32x4 o = v[rr][j] * rstd * A[j] + SH[j]; u32x2 w; w.x = cvtpk(o.x, o.y); w.y = cvtpk(o.z, o.w); *(u32x2*)(hr + 4 * lane + 256 * j) = w; }
            }
        }
    }
}

__device__ __forceinline__ void p_normrope(bf16* U, const int* pos, const float* aq, const float* ak, const float* bq, const float* bk, float* scr, int gw, int NGW, int lane) {
    const int sub = lane & 3, hsl = lane >> 2;
    const float invf = exp2f(-(float)(lane & 31) * (13.287712379549449f / 32.f));
    constexpr int NP = 1;
    int colp[NP]; float scp[NP]; bool validp[NP]; const float* gp[NP];
    { const int hs = hsl; validp[0] = hs < 10;
      if (hs < 8) { colp[0] = C_KA + 64 * hs; gp[0] = ak; scp[0] = 1.f; }
      else { colp[0] = C_KB + 64 * ((hs - 8) & 1); gp[0] = bk; scp[0] = 1.f; } }
    for (int ch = gw; ch < M / 16; ch += NGW) {
#pragma unroll 1
        for (int r0 = 0; r0 < 16; r0 += 4) {
            const int m0 = ch * 16 + r0;
            u32x4 xa[4][NP], xb[4][NP];
#pragma unroll
            for (int rr = 0; rr < 4; ++rr) { const bf16* ur = U + (size_t)(m0 + rr) * EU;
#pragma unroll
                for (int p = 0; p < NP; ++p) { xa[rr][p] = u32x4{0u, 0u, 0u, 0u}; xb[rr][p] = xa[rr][p];
                    if (validp[p]) { xa[rr][p] = *(const u32x4*)(ur + colp[p] + 8 * sub); xb[rr][p] = *(const u32x4*)(ur + colp[p] + 32 + 8 * sub); } } }
#pragma unroll
            for (int rr = 0; rr < 4; ++rr) {
                const float ang = (float)pos[m0 + rr] * invf;
                const float kq = rintf(ang * 0.15915494309189535f);
                float rd = fmaf(-kq, 6.28318548202514648f, ang); rd = fmaf(-kq, -1.74845553e-07f, rd);
                const float rv = rd * 0.15915494309189535f;
                scr[rr * 64 + lane] = (lane < 32) ? __builtin_amdgcn_cosf(rv) : __builtin_amdgcn_sinf(rv);
            }
            __builtin_amdgcn_wave_barrier();
#pragma unroll
            for (int rr = 0; rr < 4; ++rr) {
                float c8[8], s8[8];
#pragma unroll
                for (int i = 0; i < 8; ++i) { c8[i] = scr[rr * 64 + 8 * sub + i]; s8[i] = scr[rr * 64 + 32 + 8 * sub + i]; }
                bf16* ur = U + (size_t)(m0 + rr) * EU;
#pragma unroll
                for (int p = 0; p < NP; ++p) {
                    float x1[8], x2[8]; float ss = 0.f;
#pragma unroll
                    for (int i = 0; i < 4; ++i) { x1[2 * i] = bf_lo(xa[rr][p][i]); x1[2 * i + 1] = bf_hi(xa[rr][p][i]); x2[2 * i] = bf_lo(xb[rr][p][i]); x2[2 * i + 1] = bf_hi(xb[rr][p][i]); }
#pragma unroll
                    for (int i = 0; i < 8; ++i) ss += x1[i] * x1[i] + x2[i] * x2[i];
                    ss += __shfl_xor(ss, 1); ss += __shfl_xor(ss, 2);
                    const float rstd = 1.0f / sqrtf(ss * (1.f / 64.f) + EPS);
                    const float* g = gp[p]; const float sc = scp[p];
                    float o1[8], o2[8];
#pragma unroll
                    for (int i = 0; i < 8; ++i) { const float y1 = x1[i] * rstd * g[8 * sub + i], y2 = x2[i] * rstd * g[32 + 8 * sub + i];
                        o1[i] = (y1 * c8[i] - y2 * s8[i]) * sc; o2[i] = (y2 * c8[i] + y1 * s8[i]) * sc; }
                    if (validp[p]) { u32x4 wa, wb;
#pragma unroll
                        for (int i = 0; i < 4; ++i) { wa[i] = cvtpk(o1[2 * i], o1[2 * i + 1]); wb[i] = cvtpk(o2[2 * i], o2[2 * i + 1]); }
                        *(u32x4*)(ur + colp[p] + 8 * sub) = wa; *(u32x4*)(ur + colp[p] + 32 + 8 * sub) = wb; }
                }
            }
            __builtin_amdgcn_wave_barrier();
        }
    }
}

__device__ __forceinline__ void p_vt_item(const bf16* U, int ldu, int colbase, bf16* VT, int NC, int cdst0, int b, int s0, unsigned* scr, int lane) {
#pragma unroll
    for (int i = 0; i < 8; ++i) { const int row = i * 8 + (lane >> 3), ch = lane & 7;
        const u32x4 v = *(const u32x4*)(U + (size_t)(b * S + s0 + row) * ldu + colbase + 8 * ch);
        scr[row * 33 + 4 * ch + 0] = v.x; scr[row * 33 + 4 * ch + 1] = v.y; scr[row * 33 + 4 * ch + 2] = v.z; scr[row * 33 + 4 * ch + 3] = v.w; }
    __builtin_amdgcn_wave_barrier();
#pragma unroll
    for (int i = 0; i < 8; ++i) { const int c = i * 8 + (lane >> 3), ch = lane & 7; const int sh = (c & 1) * 16;
        unsigned hv[8];
#pragma unroll
        for (int k = 0; k < 8; ++k) hv[k] = (scr[(8 * ch + k) * 33 + (c >> 1)] >> sh) & 0xffffu;
        u32x4 o; o.x = hv[0] | (hv[1] << 16); o.y = hv[2] | (hv[3] << 16); o.z = hv[4] | (hv[5] << 16); o.w = hv[6] | (hv[7] << 16);
        *(u32x4*)(VT + (size_t)(b * NC + cdst0 + c) * S + s0 + 8 * ch) = o; }
    __builtin_amdgcn_wave_barrier();
}

constexpr int KROW = 144;
constexpr int KBUF_BYTES = 64 * KROW;
constexpr int VBUF128_BYTES = 128 * KROW;
constexpr int DK_BYTES = 8192, DV_BYTES = 16384;

__device__ __forceinline__ void qk_tile(f32x16& s0, f32x16& s1, const unsigned char* Kb, const bf16x8 (&qf)[4], int prow, int hi) {
    const unsigned char* k0 = Kb + prow * KROW + hi * 16;
    s0 = f32x16{}; s1 = f32x16{};
#pragma unroll
    for (int ks = 0; ks < 4; ++ks) {
        const bf16x8 a0 = *(const bf16x8*)(k0 + ks * 32), a1 = *(const bf16x8*)(k0 + 32 * KROW + ks * 32);
        s0 = MFMA32(a0, qf[ks], s0); s1 = MFMA32(a1, qf[ks], s1);
    }
}
__device__ __forceinline__ bf16x8 pack8(const f32x16& p, int base) {
    u32x4 w; w.x = cvtpk(p[base], p[base + 1]); w.y = cvtpk(p[base + 2], p[base + 3]); w.z = cvtpk(p[base + 4], p[base + 5]); w.w = cvtpk(p[base + 6], p[base + 7]);
    return __builtin_bit_cast(bf16x8, w);
}
template <int NDB>
__device__ __forceinline__ void sm_update(f32x16& s0, f32x16& s1, float& m, float& l, f32x16 (&o)[NDB], bf16x8 (&pk)[4]) {
    float mx = fmaxf(s0[0], s1[0]);
#pragma unroll
    for (int r = 1; r < 16; ++r) mx = fmaxf(mx, fmaxf(s0[r], s1[r]));
    mx = half_max(mx);
    const float mn = fmaxf(m, mx);
    if (__any(mn > m)) {
        const float f = (mn > m) ? __builtin_amdgcn_exp2f(m - mn) : 1.f;
        l *= f;
#pragma unroll
        for (int db = 0; db < NDB; ++db)
#pragma unroll
            for (int r = 0; r < 16; ++r) o[db][r] *= f;
        m = mn;
    }
    float ps = 0.f;
#pragma unroll
    for (int r = 0; r < 16; ++r) { s0[r] = __builtin_amdgcn_exp2f(s0[r] - m); s1[r] = __builtin_amdgcn_exp2f(s1[r] - m); ps += s0[r] + s1[r]; }
    l += ps;
    pk[0] = pack8(s0, 0); pk[1] = pack8(s0, 8); pk[2] = pack8(s1, 0); pk[3] = pack8(s1, 8);
}


__device__ __forceinline__ void q_norm_rope(bf16x8 (&qf)[4], const float* gain, int pos, int hi_) {
    const int hi = lane_now() >> 5; (void)hi_;
    float x[4][8]; float ss = 0.f;
#pragma unroll
    for (int ks = 0; ks < 4; ++ks) { const u32x4 w = __builtin_bit_cast(u32x4, qf[ks]);
#pragma unroll
        for (int i = 0; i < 4; ++i) { x[ks][2 * i] = bf_lo(w[i]); x[ks][2 * i + 1] = bf_hi(w[i]); } }
#pragma unroll
    for (int ks = 0; ks < 4; ++ks)
#pragma unroll
        for (int j = 0; j < 8; ++j) ss += x[ks][j] * x[ks][j];
    ss = half_sum(ss);
    const float rstd = 1.0f / sqrtf(ss * (1.f / 64.f) + EPS);
    const float fpos = (float)pos;
#pragma unroll
    for (int ks = 0; ks < 2; ++ks) {
        const f32x4 ga = *(const f32x4*)(gain + 16 * ks + 8 * hi), gb = *(const f32x4*)(gain + 16 * ks + 8 * hi + 4);
        const f32x4 gc = *(const f32x4*)(gain + 32 + 16 * ks + 8 * hi), gd = *(const f32x4*)(gain + 32 + 16 * ks + 8 * hi + 4);
#pragma unroll
        for (int j = 0; j < 8; ++j) {
            const int d = 16 * ks + 8 * hi + j;
            const float invf = exp2f(-(float)d * (13.287712379549449f / 32.f));
            const float ang = fpos * invf;
            const float kq = rintf(ang * 0.15915494309189535f);
            float rd = fmaf(-kq, 6.28318548202514648f, ang); rd = fmaf(-kq, -1.74845553e-07f, rd);
            const float rv = rd * 0.15915494309189535f;
            const float cs = __builtin_amdgcn_cosf(rv), sn = __builtin_amdgcn_sinf(rv);
            const float g1 = (j < 4) ? ga[j & 3] : gb[j & 3], g2 = (j < 4) ? gc[j & 3] : gd[j & 3];
            const float y1 = x[ks][j] * rstd * g1, y2 = x[ks + 2][j] * rstd * g2;
            x[ks][j] = (y1 * cs - y2 * sn) * QS; x[ks + 2][j] = (y2 * cs + y1 * sn) * QS;
        }
    }
#pragma unroll
    for (int ks = 0; ks < 4; ++ks) { u32x4 w;
#pragma unroll
        for (int i = 0; i < 4; ++i) w[i] = cvtpk(x[ks][2 * i], x[ks][2 * i + 1]);
        qf[ks] = __builtin_bit_cast(bf16x8, w); }
}

#define SBAR() __builtin_amdgcn_sched_barrier(0)
#define PIN(x) asm volatile("" : "+v"(x))
__device__ __forceinline__ float max3f(float a, float b, float c) { float r; asm("v_max3_f32 %0, %1, %2, %3" : "=v"(r) : "v"(a), "v"(b), "v"(c)); return r; }
template <bool FIXM> __device__ __forceinline__ void diff_unit(int b, int h, int qb, float lam, const bf16* U, const bf16* VTa, bf16* Y, const float* subg, const float* qgain, const int* pos, unsigned char* lds, int tid, int wid, int lane) {
    lane = lane_now(); tid = wid * 64 + lane;
    const int r32 = lane & 31, hi = lane >> 5, prow = pi32(r32);
    const int q0 = qb * 256, t0 = q0 + 32 * wid, tq = t0 + r32;
    const size_t rowbase = (size_t)b * S;
    const int NT = 4 * qb + 4, mylast = 4 * qb + (wid >> 1);
    f32x16 o[4];
#pragma unroll 1
    for (int c = 0; c < 2; ++c) {
        LAS unsigned char* qlds = (LAS unsigned char*)lds + 98304 + wid * 4096 + lane * 16;
        { const bf16* qp = U + (rowbase + tq) * EU + C_QA + (2 * h + c) * 64 + hi * 8; bf16x8 qraw[4];
#pragma unroll
          for (int ks = 0; ks < 4; ++ks) qraw[ks] = *(const bf16x8*)(qp + ks * 16);
          q_norm_rope(qraw, qgain, pos[rowbase + tq], hi);
#pragma unroll
          for (int ks = 0; ks < 4; ++ks) *(LAS bf16x8*)(qlds + ks * 1024) = qraw[ks]; }
#define QF(ks) (*(const LAS bf16x8*)(qlds + (ks) * 1024))
        const int srow = 8 * wid + (lane >> 3), sch = (lane & 7) ^ ((srow >> 1) & 7);
        const char* kb_u = (const char*)(U + rowbase * EU + C_KA + (2 * h + c) * 64);
        const char* vb_u = (const char*)(VTa + (size_t)(h * 128) * M + rowbase);
        const unsigned koff = (unsigned)(srow * EU + 8 * sch) * 2u, voff = (unsigned)(srow * M + 8 * sch) * 2u;
        LAS unsigned char* ldsl = (LAS unsigned char*)lds + wid * 1024;
#define DMA_K(t_, slot_) __builtin_amdgcn_global_load_lds((const unsigned*)(kb_u + (size_t)(t_) * (64 * EU * 2) + koff), (LAS unsigned*)(ldsl + (slot_) * DK_BYTES), 16, 0, 0)
#define DMA_V(t_, slot_) do { __builtin_amdgcn_global_load_lds((const unsigned*)(vb_u + (size_t)(t_) * 128 + voff), (LAS unsigned*)(ldsl + 4 * DK_BYTES + (slot_) * DV_BYTES), 16, 0, 0); \
                             __builtin_amdgcn_global_load_lds((const unsigned*)(vb_u + (size_t)(t_) * 128 + (size_t)64 * M * 2 + voff), (LAS unsigned*)(ldsl + 4 * DK_BYTES + (slot_) * DV_BYTES + 8192), 16, 0, 0); } while (0)
#define DMA_GROUP(t_) do { const int kt_ = ((t_) + 3 < NT) ? (t_) + 3 : NT - 1; int vt_ = ((t_) + 2 < NT) ? (t_) + 2 : NT - 1; vt_ = vt_ < 0 ? 0 : vt_; DMA_K(kt_, ((t_) + 3) & 3); DMA_V(vt_, ((t_) + 2) & 3); } while (0)
        DMA_GROUP(-3); DMA_GROUP(-2); DMA_GROUP(-1);
        asm volatile("s_waitcnt vmcnt(6)" ::: "memory");
        __builtin_amdgcn_s_barrier();
        float m = -INFINITY, l = 0.f;
#pragma unroll
        for (int db = 0; db < 4; ++db) o[db] = f32x16{};
        u32x4 pwA[4], pwB[4];
#pragma unroll
        for (int i = 0; i < 4; ++i) { pwA[i] = u32x4{0u, 0u, 0u, 0u}; pwB[i] = pwA[i]; }
        const LAS unsigned char* kfp = (const LAS unsigned char*)lds + prow * 128; const LAS unsigned char* vfp = (const LAS unsigned char*)lds + 4 * DK_BYTES + r32 * 128;
        unsigned kofs[4], vofs[4];
#pragma unroll
        for (int k4 = 0; k4 < 4; ++k4) { kofs[k4] = ((2 * k4 + hi) ^ ((prow >> 1) & 7)) * 16; vofs[k4] = ((2 * k4 + hi) ^ ((r32 >> 1) & 7)) * 16; }
#define KFRAG(Kb, i) (*(const LAS bf16x8*)((Kb) + ((i) & 1) * 4096 + kofs[(i) >> 1]))
#define VFRAG(Vb, j) (*(const LAS bf16x8*)((Vb) + ((j) & 3) * 4096 + vofs[(j) >> 2]))
#define DQK(T_) \
                f32x16 n0 = f32x16{}, n1 = f32x16{}; \
                { const LAS unsigned char* Kb = kfp + ((T_) & 3) * DK_BYTES; bf16x8 kf[2], qr[2]; \
                  _Pragma("unroll") for (int i = 0; i < 2; ++i) { kf[i] = KFRAG(Kb, i); qr[i] = QF(i); } \
                  SBAR(); \
                  _Pragma("unroll") for (int i = 0; i < 8; ++i) { \
                      if (i & 1) n1 = MFMA32(kf[i & 1], qr[(i >> 1) & 1], n1); else n0 = MFMA32(kf[i & 1], qr[(i >> 1) & 1], n0); \
                      if (i + 2 < 8) kf[i & 1] = KFRAG(Kb, i + 2); \
                      if ((i & 1) && (i >> 1) + 2 < 4) qr[(i >> 1) & 1] = QF((i >> 1) + 2); \
                      SBAR(); } } \
                if ((T_) == mylast) { \
                    int tqm = tq - 64 * (T_) - 8 * hi; asm volatile("" : "+v"(tqm)); \
                    _Pragma("unroll") for (int r = 0; r < 16; ++r) { const int key = 16 * (r >> 3) + (r & 7); if (key > tqm) n0[r] = -INFINITY; if (key + 32 > tqm) n1[r] = -INFINITY; } \
                } \
                bool resc = false; float mn = 0.f, f = 1.f; \
                if (!FIXM) { \
                    asm volatile("s_nop 15\n\ts_nop 7" : "+v"(n0), "+v"(n1));     \
                    float mx = max3f(n0[0], n1[0], n0[1]), mx2 = max3f(n1[1], n0[2], n1[2]); \
                    _Pragma("unroll") for (int r = 3; r < 15; r += 2) { mx = max3f(mx, n0[r], n1[r]); mx2 = max3f(mx2, n0[r + 1], n1[r + 1]); } \
                    mx = max3f(mx, n0[15], n1[15]); mx = fmaxf(mx, mx2); \
                    mx = half_max(mx); \
                    resc = __any(mx > m + 8.f); \
                    mn = resc ? fmaxf(m, mx) : m; \
                    f = (mn > m) ? __builtin_amdgcn_exp2f(m - mn) : 1.f; \
                    m = mn; } \
                float sacc = 0.f;
#define DEXP(j, PWN) { const float a0_ = ((j) < 8 ? n0[2 * ((j) & 7)] : n1[2 * ((j) & 7)]), a1_ = ((j) < 8 ? n0[2 * ((j) & 7) + 1] : n1[2 * ((j) & 7) + 1]); \
                      const float p0 = __builtin_amdgcn_exp2f(FIXM ? a0_ : a0_ - mn), p1 = __builtin_amdgcn_exp2f(FIXM ? a1_ : a1_ - mn); \
                      sacc += p0; sacc += p1; PWN[(j) >> 2][(j) & 3] = cvtpk(p0, p1); PIN(sacc); PIN(PWN[(j) >> 2]); }
#define DEND() asm volatile("s_waitcnt vmcnt(6) lgkmcnt(0)" ::: "memory"); __builtin_amdgcn_s_barrier();
#define DSTEP(T_, PWC, PWN) do { \
            DMA_GROUP(T_); \
            const LAS unsigned char* Vb = vfp + (((T_) - 1) & 3) * DV_BYTES; \
            if ((T_) <= mylast) { \
                DQK(T_) \
                bf16x8 vf[2]; \
                _Pragma("unroll") for (int j = 0; j < 2; ++j) vf[j] = VFRAG(Vb, j); \
                SBAR(); \
                _Pragma("unroll") for (int j = 0; j < 16; ++j) { \
                    o[j & 3] = MFMA32(vf[j & 1], __builtin_bit_cast(bf16x8, PWC[j >> 2]), o[j & 3]); \
                    if (j + 2 < 16) vf[j & 1] = VFRAG(Vb, j + 2); \
                    DEXP(j, PWN) \
                    SBAR(); } \
                if (resc) { l *= f; \
                    _Pragma("unroll") for (int db = 0; db < 4; ++db) _Pragma("unroll") for (int r = 0; r < 16; ++r) o[db][r] *= f; } \
                l += sacc; \
            } else if ((T_) - 1 <= mylast) { \
                _Pragma("unroll") for (int j = 0; j < 16; ++j) { const bf16x8 vf = VFRAG(Vb, j); o[j & 3] = MFMA32(vf, __builtin_bit_cast(bf16x8, PWC[j >> 2]), o[j & 3]); if ((j & 3) == 3) SBAR(); } \
            } \
            DEND() \
        } while (0)
        {
            DMA_GROUP(0);
            DQK(0)
#pragma unroll
            for (int j = 0; j < 16; ++j) DEXP(j, pwA)
            (void)resc; (void)f;
            l = sacc;
            DEND()
        }
#pragma unroll 1
        for (int t2 = 1; t2 <= NT; t2 += 2) {
            DSTEP(t2, pwA, pwB);
            if (t2 + 1 <= NT) DSTEP(t2 + 1, pwB, pwA);
        }
#undef DSTEP
#undef DQK
#undef DEXP
#undef DEND
        asm volatile("s_waitcnt vmcnt(0)" ::: "memory");
        __builtin_amdgcn_s_barrier();
#undef KFRAG
#undef VFRAG
#undef QF
#undef DMA_K
#undef DMA_V
#undef DMA_GROUP
        const float inv = 1.0f / half_sum(l);
        bf16* yst = Y + (rowbase + tq) * D + h * 128 + 8 * hi;
        if (c == 0) {
#pragma unroll
            for (int db = 0; db < 4; ++db)
#pragma unroll
                for (int p2 = 0; p2 < 2; ++p2) { u32x4 w;
#pragma unroll
                    for (int e = 0; e < 4; ++e) w[e] = cvtpk(o[db][8 * p2 + 2 * e] * inv, o[db][8 * p2 + 2 * e + 1] * inv);
                    *(u32x4*)(yst + 32 * db + 16 * p2) = w; }
        } else {
            const float li = lam * inv;
#pragma unroll
            for (int db = 0; db < 4; ++db)
#pragma unroll
                for (int p2 = 0; p2 < 2; ++p2) { const u32x4 w = *(const u32x4*)(yst + 32 * db + 16 * p2);
#pragma unroll
                    for (int e = 0; e < 4; ++e) { o[db][8 * p2 + 2 * e] = bf_lo(w[e]) - o[db][8 * p2 + 2 * e] * li; o[db][8 * p2 + 2 * e + 1] = bf_hi(w[e]) - o[db][8 * p2 + 2 * e + 1] * li; } }
        }
    }
    float ss = 0.f;
#pragma unroll
    for (int db = 0; db < 4; ++db)
#pragma unroll
        for (int r = 0; r < 16; ++r) ss += o[db][r] * o[db][r];
    ss = half_sum(ss);
    const float rstd = 0.8f / sqrtf(ss * (1.f / 128.f) + EPS);
    const int lane_e = lane_now();
    const int hi_e = lane_e >> 5, tq_e = t0 + (lane_e & 31);
    const bf16* gar = U + (rowbase + tq_e) * EU + C_GA + h * 128;
    bf16* yr = Y + (rowbase + tq_e) * D + h * 128; u32x2 wprev = {0u, 0u};
#pragma unroll
    for (int db = 0; db < 4; ++db)
#pragma unroll
        for (int g4 = 0; g4 < 4; ++g4) {
            const int e = 32 * db + 8 * g4 + 4 * hi_e;
            const u32x2 gw = *(const u32x2*)(gar + e); const f32x4 sg = *(const f32x4*)(subg + e);
            const float y0 = o[db][4 * g4 + 0] * rstd * sg.x * silu_f(bf_lo(gw.x)), y1 = o[db][4 * g4 + 1] * rstd * sg.y * silu_f(bf_hi(gw.x));
            const float y2 = o[db][4 * g4 + 2] * rstd * sg.z * silu_f(bf_lo(gw.y)), y3 = o[db][4 * g4 + 3] * rstd * sg.w * silu_f(bf_hi(gw.y));
            u32x2 w; w.x = cvtpk(y0, y1); w.y = cvtpk(y2, y3);
            if ((g4 & 1) == 0) wprev = w; else store_pair16(yr + 32 * db + 16 * (g4 >> 1) + 8 * hi_e, wprev, w);
        }
}

__device__ __forceinline__ void swa_unit(int b, int kvh, int qb, const bf16* U, const bf16* VTb, bf16* Y, const float* sinks, const float* qgain, const int* pos, unsigned char* lds, int wid, int lane) {
    const int r32 = lane & 31, hi = lane >> 5, prow = pi32(r32);
    const int q0 = qb * 256, t0 = q0 + 32 * wid, tq = t0 + r32;
    const size_t rowbase = (size_t)b * S;
    const int T0 = (q0 >= 128) ? (q0 - 128) >> 6 : 0, T1 = (q0 + 255) >> 6, nT = T1 - T0 + 1;
    {
        const int srow = 8 * wid + (lane >> 3), sch = (lane & 7) ^ ((srow >> 1) & 7);
        const char* kb_u = (const char*)(U + (rowbase + 64 * T0) * EU + C_KB + kvh * 64);
        const char* vb_u = (const char*)(VTb + ((size_t)(b * 128 + kvh * 64)) * S + 64 * T0);
        const unsigned koff = (unsigned)(srow * EU + 8 * sch) * 2u, voff = (unsigned)(srow * S + 8 * sch) * 2u;
        LAS unsigned char* ldsl = (LAS unsigned char*)lds + wid * 1024;
#pragma unroll 1
        for (int s = 0; s < nT; ++s) {
            __builtin_amdgcn_global_load_lds((const unsigned*)(kb_u + (size_t)s * (64 * EU * 2) + koff), (LAS unsigned*)(ldsl + s * 8192), 16, 0, 0);
            __builtin_amdgcn_global_load_lds((const unsigned*)(vb_u + (size_t)s * 128 + voff), (LAS unsigned*)(ldsl + 49152 + s * 8192), 16, 0, 0);
        }
        asm volatile("s_waitcnt vmcnt(0)" ::: "memory");
        __syncthreads();
    }
    const LAS unsigned char* kfp = (const LAS unsigned char*)lds + prow * 128; const LAS unsigned char* vfp = (const LAS unsigned char*)lds + 49152 + r32 * 128;
    unsigned kofs[4], vofs[4];
#pragma unroll
    for (int k4 = 0; k4 < 4; ++k4) { kofs[k4] = ((2 * k4 + hi) ^ ((prow >> 1) & 7)) * 16; vofs[k4] = ((2 * k4 + hi) ^ ((r32 >> 1) & 7)) * 16; }
    const int tlo = (t0 >= 127) ? (t0 - 127) >> 6 : 0, thi = (t0 + 31) >> 6;
#pragma unroll 1
    for (int g = 0; g < 4; ++g) {
        const int qh = kvh * 4 + g;
        bf16x8 qf[4];
        { const bf16* qp = U + (rowbase + tq) * EU + C_QB + qh * 64 + hi * 8;
#pragma unroll
          for (int ks = 0; ks < 4; ++ks) qf[ks] = *(const bf16x8*)(qp + ks * 16); }
        q_norm_rope(qf, qgain, pos[rowbase + tq], hi);
        float m = sinks[qh] * LOG2E, l = (hi == 0) ? 1.f : 0.f;
        f32x16 o[2]; o[0] = f32x16{}; o[1] = f32x16{};
#pragma unroll 1
        for (int t = tlo; t <= thi; ++t) {
            const LAS unsigned char* Kb = kfp + (t - T0) * 8192; const LAS unsigned char* Vb = vfp + (t - T0) * 8192;
            f32x16 s0 = f32x16{}, s1 = f32x16{};
#pragma unroll
            for (int ks = 0; ks < 4; ++ks) { const bf16x8 a0 = *(const LAS bf16x8*)(Kb + kofs[ks]), a1 = *(const LAS bf16x8*)(Kb + 4096 + kofs[ks]); s0 = MFMA32(a0, qf[ks], s0); s1 = MFMA32(a1, qf[ks], s1); }
            const int rel = tq - 64 * t - 8 * hi;
#pragma unroll
            for (int r = 0; r < 16; ++r) { const int key = 16 * (r >> 3) + (r & 7);
                if (key > rel || rel - key >= 128) s0[r] = -INFINITY;
                if (key + 32 > rel || rel - (key + 32) >= 128) s1[r] = -INFINITY; }
            bf16x8 pk[4]; sm_update<2>(s0, s1, m, l, o, pk);
#pragma unroll
            for (int db = 0; db < 2; ++db)
#pragma unroll
                for (int kk = 0; kk < 4; ++kk) { const bf16x8 vf = *(const LAS bf16x8*)(Vb + db * 4096 + vofs[kk]); o[db] = MFMA32(vf, pk[kk], o[db]); }
        }
        const float inv = 1.0f / half_sum(l);
        const bf16* gbr = U + (rowbase + tq) * EU + C_GB + qh * 64;
        bf16* yr = Y + (rowbase + tq) * D + 512 + qh * 64; u32x2 wprev = {0u, 0u};
#pragma unroll
        for (int db = 0; db < 2; ++db)
#pragma unroll
            for (int g4 = 0; g4 < 4; ++g4) {
                const int e = 32 * db + 8 * g4 + 4 * hi;
                const u32x2 gw = *(const u32x2*)(gbr + e);
                const float y0 = o[db][4 * g4 + 0] * inv * silu_f(bf_lo(gw.x)), y1 = o[db][4 * g4 + 1] * inv * silu_f(bf_hi(gw.x));
                const float y2 = o[db][4 * g4 + 2] * inv * silu_f(bf_lo(gw.y)), y3 = o[db][4 * g4 + 3] * inv * silu_f(bf_hi(gw.y));
                u32x2 w; w.x = cvtpk(y0, y1); w.y = cvtpk(y2, y3);
                if ((g4 & 1) == 0) wprev = w; else store_pair16(yr + 32 * db + 16 * (g4 >> 1) + 8 * hi, wprev, w);
            }
    }
    __syncthreads();
}

__device__ __forceinline__ void sb_unit(int b, int h, int qb, const bf16* U, const bf16* VT, bf16* Y, unsigned char* lds, int wid, int lane, int& res_lo, int& res_hi) {
    lane = lane_now();
    const int r32 = lane & 31, hi = lane >> 5, prow = pi32(r32);
    const int q0 = qb * 256, t0 = q0 + 32 * wid, tq = t0 + r32;
    const size_t rowbase = (size_t)b * S;
    const int mytile = 4 * qb + (wid >> 1);
    bf16x8 TM[2], JN;
#pragma unroll
    for (int s2 = 0; s2 < 2; ++s2)
#pragma unroll
        for (int j = 0; j < 8; ++j) TM[s2][j] = (16 * s2 + 8 * hi + j > prow) ? (short)0xBF80 : (short)0;
#pragma unroll
    for (int j = 0; j < 8; ++j) JN[j] = (short)0xBF80;
    bf16x8 qf[4];
    { const bf16* qp = U + (rowbase + tq) * U1LD + h * 64 + hi * 8;
#pragma unroll
      for (int ks = 0; ks < 4; ++ks) qf[ks] = *(const bf16x8*)(qp + ks * 16); }
    u32x2 gwv[2][4];
    { const bf16* gr0 = U + (rowbase + tq) * U1LD + 2048 + h * 64 + 4 * hi;
#pragma unroll
      for (int db = 0; db < 2; ++db)
#pragma unroll
          for (int g4 = 0; g4 < 4; ++g4) gwv[db][g4] = *(const u32x2*)(gr0 + 32 * db + 8 * g4); }
    const int srow = 8 * wid + (lane >> 3), sch = (lane & 7) ^ ((srow >> 1) & 7);
    const char* kb_u = (const char*)(U + rowbase * U1LD + 1024 + h * 64);
    const char* vb_u = (const char*)(VT + (size_t)(h * 64) * M + rowbase);
    const unsigned koff = (unsigned)(srow * U1LD + 8 * sch) * 2u, voff = (unsigned)(srow * M + 8 * sch) * 2u;
    LAS unsigned char* ldsl = (LAS unsigned char*)lds + wid * 1024;
    const LAS unsigned char* kfp = (const LAS unsigned char*)lds + prow * 128; const LAS unsigned char* vfp = (const LAS unsigned char*)lds + 8192 + r32 * 128;
    unsigned kofs[4], vofs[4];
#pragma unroll
    for (int k4 = 0; k4 < 4; ++k4) { kofs[k4] = ((2 * k4 + hi) ^ ((prow >> 1) & 7)) * 16; vofs[k4] = ((2 * k4 + hi) ^ ((r32 >> 1) & 7)) * 16; }
    f32x16 C = f32x16{}; f32x16 o[2]; o[0] = f32x16{}; o[1] = f32x16{};
    bool alive = true;
    volatile unsigned* flg = (volatile unsigned*)(lds + LDS_MISC + 128);
#pragma unroll 1
    for (int top = 4 * qb + 3; ; top -= 7) {
        const int lo = (top >= 6) ? top - 6 : 0;
#pragma unroll 1
        for (int t = top; t >= lo; --t) {
            if (t >= res_lo && t <= res_hi) continue;
            __builtin_amdgcn_global_load_lds((const unsigned*)(kb_u + (size_t)t * (64 * U1LD * 2) + koff), (LAS unsigned*)(ldsl + (t & 7) * 16384), 16, 0, 0);
            __builtin_amdgcn_global_load_lds((const unsigned*)(vb_u + (size_t)t * 128 + voff), (LAS unsigned*)(ldsl + (t & 7) * 16384 + 8192), 16, 0, 0);
        }
        { const int nh = (res_hi < lo + 7) ? res_hi : lo + 7; res_hi = (nh > top) ? nh : top; res_lo = lo; if (res_hi > lo + 7) res_hi = lo + 7; }
        asm volatile("s_waitcnt vmcnt(0)" ::: "memory");
        __syncthreads();
#pragma unroll 1
        for (int t = (top < mytile ? top : mytile); t >= lo && alive; --t) {
            const LAS unsigned char* Kb = kfp + (t & 7) * 16384; const LAS unsigned char* Vb = vfp + (t & 7) * 16384;
            f32x16 y0 = f32x16{}, y1 = f32x16{};
#pragma unroll
            for (int ks = 0; ks < 4; ++ks) { const bf16x8 a0 = *(const LAS bf16x8*)(Kb + kofs[ks]), a1 = *(const LAS bf16x8*)(Kb + 4096 + kofs[ks]); y0 = MFMA32(a0, qf[ks], y0); y1 = MFMA32(a1, qf[ks], y1); }
#pragma unroll
            for (int r = 0; r < 16; ++r) { y0[r] = fminf(y0[r], 100.f); y1[r] = fminf(y1[r], 100.f); }
            if (t == mytile) {
                int tqm = tq - 64 * t - 8 * hi; asm volatile("" : "+v"(tqm));
#pragma unroll
                for (int r = 0; r < 16; ++r) { const int key = 16 * (r >> 3) + (r & 7); if (key >= tqm) y0[r] = -INFINITY; if (key + 32 >= tqm) y1[r] = -INFINITY; }
            }
            f32x16 l0, l1;
#pragma unroll
            for (int r = 0; r < 16; ++r) { l0[r] = __builtin_amdgcn_logf(1.f + __builtin_amdgcn_exp2f(y0[r])); l1[r] = __builtin_amdgcn_logf(1.f + __builtin_amdgcn_exp2f(y1[r])); }
            bf16x8 lb[4]; lb[0] = pack8(l0, 0); lb[1] = pack8(l0, 8); lb[2] = pack8(l1, 0); lb[3] = pack8(l1, 8);
#pragma unroll
            for (int r = 0; r < 16; ++r) { y0[r] -= l0[r]; y1[r] -= l1[r]; }
            f32x16 X = MFMA32(JN, lb[2], C); X = MFMA32(JN, lb[3], X);
            f32x16 f1 = MFMA32(TM[0], lb[2], C); f1 = MFMA32(TM[1], lb[3], f1);
            f32x16 f0 = MFMA32(TM[0], lb[0], X); f0 = MFMA32(TM[1], lb[1], f0);
            C = MFMA32(JN, lb[0], X); C = MFMA32(JN, lb[1], C);
#pragma unroll
            for (int r = 0; r < 16; ++r) { y0[r] = __builtin_amdgcn_exp2f(y0[r] + f0[r]); y1[r] = __builtin_amdgcn_exp2f(y1[r] + f1[r]); }
            bf16x8 pk[4]; pk[0] = pack8(y0, 0); pk[1] = pack8(y0, 8); pk[2] = pack8(y1, 0); pk[3] = pack8(y1, 8);
#pragma unroll
            for (int db = 0; db < 2; ++db)
#pragma unroll
                for (int kk = 0; kk < 4; ++kk) { const bf16x8 vf = *(const LAS bf16x8*)(Vb + db * 4096 + vofs[kk]); o[db] = MFMA32(vf, pk[kk], o[db]); }
            alive = __any(C[0] > -160.f);
        }
        if (lo == 0) break;
        if (lane == 0) flg[wid] = alive ? 1u : 0u;
        __syncthreads();
        const bool any_alive = __any(flg[lane & 7] != 0u);
        if (!any_alive) break;
        __syncthreads();
    }
    __syncthreads();
    const int lane_e = lane_now(); const int hi_e = lane_e >> 5, tq_e = t0 + (lane_e & 31);
    bf16* yr = Y + (rowbase + tq_e) * D + h * 64; u32x2 wprev = {0u, 0u};
#pragma unroll
    for (int db = 0; db < 2; ++db)
#pragma unroll
        for (int g4 = 0; g4 < 4; ++g4) {
            const int e = 32 * db + 8 * g4 + 4 * hi_e;
            const u32x2 gw = gwv[db][g4];
            const float y0 = o[db][4 * g4 + 0] * silu_f(bf_lo(gw.x)), y1 = o[db][4 * g4 + 1] * silu_f(bf_hi(gw.x));
            const float y2 = o[db][4 * g4 + 2] * silu_f(bf_lo(gw.y)), y3 = o[db][4 * g4 + 3] * silu_f(bf_hi(gw.y));
            u32x2 w; w.x = cvtpk(y0, y1); w.y = cvtpk(y2, y3);
            if ((g4 & 1) == 0) wprev = w; else store_pair16(yr + 32 * db + 16 * (g4 >> 1) + 8 * hi_e, wprev, w);
        }
}

#define XB_TMO      128
#define XB_XCNT(j)  (256  + 64 * (j))
#define XB_XSUB(j)  (1280 + 64 * (j))
#define XB_XGEN(j)  (2304 + 64 * (j))
#define XB_TOP      3328
#define XB_TOPGEN   3392
#define XCD_BAR_WORDS 3456
#define XB_SPIN_CAP (1u << 18)

__device__ __forceinline__ unsigned xb_ld(unsigned* p)              { return __hip_atomic_load(p, __ATOMIC_RELAXED, __HIP_MEMORY_SCOPE_AGENT); }
__device__ __forceinline__ unsigned xb_add(unsigned* p, unsigned v) { return __hip_atomic_fetch_add(p, v, __ATOMIC_RELAXED, __HIP_MEMORY_SCOPE_AGENT); }
__device__ __forceinline__ unsigned xb_xcc_id() { return (unsigned)__builtin_amdgcn_s_getreg((3 << 11) | 20) & 0xFu; }
#define XB_SPIN(cond, bar) do { unsigned _sp = 0; while (cond) { __builtin_amdgcn_s_sleep(1); \
    if ((++_sp & 255u) == 0u) { if (xb_ld(&(bar)[XB_TMO])) break; if (_sp > XB_SPIN_CAP) { atomicAdd(&(bar)[XB_TMO], 1u); break; } } } } while (0)

struct XcdBarrier {
    unsigned* bar; unsigned x;
    volatile LAS unsigned* st;
};

__device__ __forceinline__ XcdBarrier xcd_barrier_post(unsigned* bar, volatile LAS unsigned* st, bool t0) {
    XcdBarrier b; b.bar = bar; b.x = xb_xcc_id(); b.st = st;
    if (t0) (void)xb_add(&bar[XB_XCNT(b.x)], 1u);
    return b;
}
__device__ __forceinline__ void xcd_barrier_complete(unsigned* bar, unsigned x, unsigned& nloc, unsigned& nx) {
    const unsigned G = gridDim.x * gridDim.y * gridDim.z;
    unsigned sum, cnt, mine, sp = 0u;
    for (;;) {
        sum = 0u; cnt = 0u; mine = 0u;
#pragma unroll
        for (unsigned j = 0; j < 16; ++j) { const unsigned c = xb_ld(&bar[XB_XCNT(j)]); sum += c; cnt += (c > 0u) ? 1u : 0u; mine = (j == x) ? c : mine; }
        if (sum == G) break;
        __builtin_amdgcn_s_sleep(1);
        if ((++sp & 255u) == 0u) { if (xb_ld(&bar[XB_TMO])) break; if (sp > XB_SPIN_CAP) { atomicAdd(&bar[XB_TMO], 1u); break; } }
    }
    nloc = mine > 0u ? mine : 1u; nx = cnt > 0u ? cnt : 1u;
}

__device__ __forceinline__ void xcd_barrier(const XcdBarrier& b, bool t0) {
    asm volatile("s_waitcnt vmcnt(0)" ::: "memory");
    __syncthreads();
    if (t0) {
        unsigned* bar = b.bar;
        __builtin_amdgcn_s_waitcnt(0);
        unsigned nloc = b.st[0], nx = b.st[1];
        if (nloc == 0u) { xcd_barrier_complete(bar, b.x, nloc, nx); b.st[0] = nloc; b.st[1] = nx; }
        const unsigned old = xb_add(&bar[XB_XSUB(b.x)], 1u);
        const unsigned gen = old / nloc;
        if (old + 1u == (gen + 1u) * nloc) {
            __builtin_amdgcn_fence(__ATOMIC_RELEASE, "agent");
            asm volatile("s_waitcnt vmcnt(0)" ::: "memory");
            const unsigned og = xb_add(&bar[XB_TOP], 1u);
            const unsigned tg = og / nx;
            if (og + 1u == (tg + 1u) * nx) xb_add(&bar[XB_TOPGEN], 1u);
            else XB_SPIN(xb_ld(&bar[XB_TOPGEN]) == tg, bar);
            __builtin_amdgcn_fence(__ATOMIC_ACQUIRE, "agent");
            xb_add(&bar[XB_XGEN(b.x)], 1u);
            asm volatile("s_waitcnt vmcnt(0)" ::: "memory");
        } else {
            XB_SPIN(xb_ld(&bar[XB_XGEN(b.x)]) == gen, bar);
            __builtin_amdgcn_fence(__ATOMIC_ACQUIRE, "agent");
            asm volatile("s_waitcnt vmcnt(0)" ::: "memory");
        }
    }
    __syncthreads();
}

#ifndef MK_SINGLE
#define MK_SINGLE 1
#endif
constexpr int NPHASE = 11;
struct Args { const float* in[23]; float* out; unsigned char* ws; int ph_lo, ph_hi; };

__global__ void __launch_bounds__(NWAVES * 64, 2) hybrid_fwd(Args args) {
    extern __shared__ __attribute__((aligned(16))) unsigned char lds[];
    const int wid = __builtin_amdgcn_readfirstlane((int)threadIdx.x >> 6);
    const int G = gridDim.x; const int bx = blockIdx.x;
    const int vcu = (G % 8 == 0) ? (bx % 8) * (G / 8) + bx / 8 : bx;
    const int gw = vcu * NWAVES + wid, NGW = G * NWAVES;
#define LANE_TID() const int lane = lane_now(); const int tid = wid * 64 + lane; (void)tid
    unsigned char* ws = args.ws;
    const float* x = args.in[0]; const float* cvec = args.in[1]; const int* pos = (const int*)args.in[2];
    float* mod_e = (float*)(ws + WS_MOD); float* mod_o = mod_e + 4 * 3072;
    bf16* WinE = (bf16*)(ws + WS_WINE); bf16* WoutE = (bf16*)(ws + WS_WOUTE); bf16* WinO = (bf16*)(ws + WS_WINO); bf16* WoutO = (bf16*)(ws + WS_WOUTO);
    bf16* H = (bf16*)(ws + WS_H); bf16* Y = H; bf16* VT = (bf16*)(ws + WS_VT); bf16* U = (bf16*)(ws + WS_U);
    bf16* VTa = VT; bf16* VTb = VT + (size_t)512 * M;
    float* scrf = (float*)(lds + LDS_SCR + wid * 8448);
    const int lo = args.ph_lo, hi_ph = args.ph_hi;
#define IN(k) (lo <= (k) && (k) < hi_ph)
#define SEAM(k) do { if (IN(k) && IN((k) + 1)) { xcd_barrier(bar, wid == 0 && lane_now() == 0); } } while (0)
    if (args.ph_lo < 0) cg::this_grid().sync();
    volatile LAS unsigned* MISC = (volatile LAS unsigned*)((LAS unsigned char*)lds + LDS_MISC);
    if (wid == 0) MISC[lane_now()] = 0u;
    __syncthreads();
    XcdBarrier bar = xcd_barrier_post((unsigned*)(ws + WS_BAR), MISC + 8, wid == 0 && lane_now() == 0);

    if (IN(0)) {
        LANE_TID();
        if (bx < 192) p0_silu_to_lds(cvec, (float*)lds + 1024, tid);
        for (int it = bx; it < 192; it += G) {
            const int l = it / 96, j0 = (it % 96) * 32;
            p0_mod_item((const float*)lds + 1024, l ? args.in[19] : args.in[4], (l ? args.in[20] : args.in[5]), l ? mod_o : mod_e, j0, (float*)lds, wid, lane, tid);
        }
        constexpr int I_INE = 16 * (EIN / 32), I_OUT = 16 * (D / 32), I_INO = 16 * (OIN / 32);
        constexpr int NITEMS = I_INE + I_OUT + I_INO + I_OUT;
        for (int it = gw; it < NITEMS; it += NGW) {
            int r = it;
            if (r < I_INE) { p0_transpose_item(args.in[6], D, EIN, WinE, scrf, r, lane, 0, 1.f, 2); continue; } r -= I_INE;
            if (r < I_OUT) { p0_transpose_item(args.in[17], D, D, WoutE, scrf, r, lane, 0, 1.f, 0); continue; } r -= I_OUT;
            if (r < I_INO) { p0_transpose_item(args.in[21], D, OIN, WinO, scrf, r, lane, 1024, QS, 1); continue; } r -= I_INO;
            p0_transpose_item(args.in[22], D, D, WoutO, scrf, r, lane, 0, 1.f, 0);
        }
    }
    SEAM(0);
    if (IN(1)) { LANE_TID(); p_hrows(x, H, args.in[3], mod_e, gw, NGW, lane); }
    SEAM(1);
    if (IN(2)) {
        { pg8::Gemm g{H, WinE, M, EU, D}; pg8::StaticOrder So; So.init(M, EU, G, bx);
          pg8::EpiStore E{U, EU};
          pg8::gemm_phase<pg8::EpiStore, pg8::StaticOrder, true, true>((PG8_LAS unsigned char*)lds, g, So, E, wid); }
        { pg8::Gemm g{WinE + (size_t)EU * D, H, 512, M, D}; pg8::StaticOrder So; So.init(512, M, G, bx);
          pg8::EpiStore E{VTa, M};
          pg8::gemm_phase<pg8::EpiStore, pg8::StaticOrder, true, true>((PG8_LAS unsigned char*)lds, g, So, E, wid); }
    }
    SEAM(2);
    if (IN(3)) {
        LANE_TID();
        p_normrope(U, pos, args.in[7], args.in[8], args.in[14], args.in[15], scrf, gw, NGW, lane);
        for (int it = gw; it < 4 * 128 * 2; it += NGW) {
            const int ct = it & 1, st = (it >> 1) & 127, b = it >> 8;
            p_vt_item(U, EU, C_VB + 64 * ct, VTb, 128, 64 * ct, b, 64 * st, (unsigned*)scrf, lane);
        }
    }
    SEAM(3);
    if (IN(4)) {
        const int lane4 = lane_now(); const int tid4 = wid * 64 + lane4;
        float lam;
        { const float p1 = args.in[9][lane4] * args.in[10][lane4], p2 = args.in[11][lane4] * args.in[12][lane4];
          lam = expf(wave_sum(p1)) - expf(wave_sum(p2)) + 0.2f; }
        bool fixm;
        { float gq = fabsf(args.in[7][lane4]), gk = fabsf(args.in[8][lane4]);
#pragma unroll
          for (int o2 = 1; o2 < 64; o2 <<= 1) { gq = fmaxf(gq, __shfl_xor(gq, o2)); gk = fmaxf(gk, __shfl_xor(gk, o2)); }
          fixm = (8.f * gq * gk * LOG2E <= 100.f); }
#ifndef NO_DIFF
        for (int p = vcu; p < 256; p += G) {
            const int bh = p >> 4, s = p & 15;
#pragma unroll 1
            for (int hf = 0; hf < 2; ++hf) {
                if (fixm) diff_unit<true>(bh >> 2, bh & 3, hf ? 31 - s : s, lam, U, VTa, Y, args.in[13], args.in[7], pos, lds, tid4, wid, lane4);
                else diff_unit<false>(bh >> 2, bh & 3, hf ? 31 - s : s, lam, U, VTa, Y, args.in[13], args.in[7], pos, lds, tid4, wid, lane4);
            }
        }
#endif
        const int lane4b = lane_now();
#ifndef NO_SWA
        for (int u = vcu; u < 256; u += G) swa_unit(u >> 6, (u >> 5) & 1, u & 31, U, VTb, Y, args.in[16], args.in[14], pos, lds, wid, lane4b);
#endif
    }
    SEAM(4);
    if (IN(5)) {
        pg8::Gemm g{Y, WoutE, M, D, D}; pg8::StaticOrder So; So.init(M, D, G, bx);
        pg8::EpiResid E{x, args.out, mod_e + 2048};
        pg8::gemm_phase<pg8::EpiResid, pg8::StaticOrder, true, true>((PG8_LAS unsigned char*)lds, g, So, E, wid);
    }
    SEAM(5);
    if (IN(6)) { LANE_TID(); p_hrows(args.out, H, args.in[18], mod_o, gw, NGW, lane); }
    SEAM(6);
    if (IN(7)) {
        { pg8::Gemm g{H, WinO, M, U1LD, D}; pg8::StaticOrder So; So.init(M, U1LD, G, bx);
          pg8::EpiStore E{U, U1LD};
          pg8::gemm_phase<pg8::EpiStore, pg8::StaticOrder, true, true>((PG8_LAS unsigned char*)lds, g, So, E, wid); }
        { pg8::Gemm g{WinO + (size_t)U1LD * D, H, 1024, M, D}; pg8::StaticOrder So; So.init(1024, M, G, bx);
          pg8::EpiStore E{VT, M};
          pg8::gemm_phase<pg8::EpiStore, pg8::StaticOrder, true, true>((PG8_LAS unsigned char*)lds, g, So, E, wid); }
    }
    SEAM(7);
    if (IN(9)) {
        const int lane9 = lane_now(); const int tid9 = wid * 64 + lane9;
        for (int run = vcu; run < 256; run += G) {
            const int bh = run >> 2; int res_lo = 1 << 30, res_hi = -1;
#pragma unroll 1
            for (int i = 7; i >= 0; --i) sb_unit(bh >> 4, bh & 15, (run & 3) * 8 + i, U, VT, Y, lds, wid, lane9, res_lo, res_hi);
        }
    }
    SEAM(9);
    if (IN(10)) {
        pg8::Gemm g{Y, WoutO, M, D, D}; pg8::StaticOrder So; So.init(M, D, G, bx);
        pg8::EpiResid E{args.out, args.out, mod_o + 2048};
        pg8::gemm_phase<pg8::EpiResid, pg8::StaticOrder, true, true>((PG8_LAS unsigned char*)lds, g, So, E, wid);
    }
#undef IN
#undef SEAM
}

extern "C" void kernel_launch(void* const* d_in, const int* in_sizes, int n_in, void* d_out, int out_size, void* d_ws, size_t ws_size, hipStream_t stream) {
    static int grid = 0;
    if (grid == 0) {
        if (n_in != 23 || out_size != M * D || ws_size < WS_END) { fprintf(stderr, "kernel_launch: unexpected shapes (n_in %d out %d ws %zu)\n", n_in, out_size, ws_size); grid = -1; return; }
        int dev = 0, cus = 0, per_cu = 0;
        hipGetDevice(&dev); hipDeviceGetAttribute(&cus, hipDeviceAttributeMultiprocessorCount, dev);
        if (hipFuncSetAttribute((const void*)hybrid_fwd, hipFuncAttributeMaxDynamicSharedMemorySize, LDS_BYTES) != hipSuccess) { fprintf(stderr, "kernel_launch: hipFuncSetAttribute failed\n"); grid = -1; return; }
        hipOccupancyMaxActiveBlocksPerMultiprocessor(&per_cu, (const void*)hybrid_fwd, NWAVES * 64, LDS_BYTES);
        (void)hipGetLastError();
        if (per_cu < 1) per_cu = 1;
        grid = cus * 1;
        if (grid <= 0) grid = 256;
    }
    if (grid < 0) return;
    if (hipMemsetAsync((char*)d_ws + WS_BAR, 0, XCD_BAR_WORDS * 4, stream) != hipSuccess) { fprintf(stderr, "kernel_launch: memset failed\n"); return; }
    Args a{};
    for (int i = 0; i < 23; ++i) a.in[i] = (const float*)d_in[i];
    a.out = (float*)d_out; a.ws = (unsigned char*)d_ws;
#if MK_SINGLE
    a.ph_lo = 0; a.ph_hi = NPHASE;
    void* kargs[] = {&a};
    hipError_t e = hipLaunchCooperativeKernel((const void*)hybrid_fwd, dim3(grid), dim3(NWAVES * 64), kargs, LDS_BYTES, stream);
    if (e != hipSuccess) fprintf(stderr, "cooperative launch failed: %s (grid %d)\n", hipGetErrorString(e), grid);
#else
    for (int ph = 0; ph < NPHASE; ++ph) {
        a.ph_lo = ph; a.ph_hi = ph + 1;
        hipLaunchKernelGGL(hybrid_fwd, dim3(grid), dim3(NWAVES * 64), LDS_BYTES, stream, a);
    }
#endif
}
```
